# Optimizing an MI355X kernel written in HIP

```python
import math
import jax, jax.numpy as jnp
from jax import lax
import numpy as np

D_MODEL = 1024
BATCH = 32
SEQ = 2048
DEPTH = 4

HEAD_DIM = 64
A_HEADS = 4
A_WIDTH = A_HEADS * HEAD_DIM
B_WIDTH = 256
SHORT_CONV = 3
C_WIDTH = 256
CONF_CONV = 31
D_Q_HEADS = 8
D_KV_HEADS = 2
D_GROUP = D_Q_HEADS // D_KV_HEADS
D_WIDTH = D_Q_HEADS * HEAD_DIM
D_KV_WIDTH = D_KV_HEADS * HEAD_DIM
WINDOW = 128
Q_BLOCK = 128
N_BRANCH = 4
REL_BUCKETS = 32
REL_MAX_DIST = 128
PLE_DIM = 256
D_FF = 2816
EPS = 1e-6
NEG_INF = -1e30

A_QKV_END = 3 * A_WIDTH
A_F_END = A_QKV_END + A_HEADS
B_END = A_F_END + 3 * B_WIDTH
C_END = B_END + 2 * C_WIDTH
D_END = C_END + D_WIDTH + 2 * D_KV_WIDTH
N_IN = D_END + N_BRANCH * D_MODEL

kernel_name = 'hybrid_gated_parallel_mixer'


def rms_norm(x, g):
    xf = x.astype(jnp.float32)
    y = xf * lax.rsqrt(jnp.mean(xf * xf, axis=-1, keepdims=True) + EPS)
    return (y * g.astype(jnp.float32)).astype(x.dtype)


def layer_norm(x, g, b):
    xf = x.astype(jnp.float32)
    mu = jnp.mean(xf, axis=-1, keepdims=True)
    xc = xf - mu
    y = xc * lax.rsqrt(jnp.mean(xc * xc, axis=-1, keepdims=True) + EPS)
    return (y * g.astype(jnp.float32) + b.astype(jnp.float32)).astype(x.dtype)


def swiglu_ffn(x, w_gu, w_down):
    gate, up = jnp.split(x @ w_gu, 2, axis=-1)
    return (jax.nn.silu(gate) * up) @ w_down


def causal_depthwise_conv(x, w):
    K, C = w.shape
    return lax.conv_general_dilated(
        x, w[:, None, :].astype(x.dtype), window_strides=(1,), padding=[(K - 1, 0)],
        dimension_numbers=('NWC', 'WIO', 'NWC'), feature_group_count=C)


def t5_causal_bucket(dist):
    max_exact = REL_BUCKETS // 2
    large = max_exact + (jnp.log(jnp.maximum(dist, 1).astype(jnp.float32) / max_exact)
                         / math.log(REL_MAX_DIST / max_exact)
                         * (REL_BUCKETS - max_exact)).astype(jnp.int32)
    large = jnp.minimum(large, REL_BUCKETS - 1)
    return jnp.where(dist < max_exact, dist, large)


def forgetting_attention(q, k, v, log_f):
    S, d = q.shape[1], q.shape[3]
    c = jnp.transpose(jnp.cumsum(log_f, axis=1), (0, 2, 1))
    scale = d ** -0.5
    outs = []
    for blk in range(S // Q_BLOCK):
        q0 = blk * Q_BLOCK
        end = q0 + Q_BLOCK
        s = jnp.einsum('bqhd,bkhd->bhqk', q[:, q0:end], k[:, :end]).astype(jnp.float32) * scale
        decay = c[:, :, q0:end, None] - c[:, :, None, :end]
        causal = (q0 + jnp.arange(Q_BLOCK))[:, None] >= jnp.arange(end)[None, :]
        s = jnp.where(causal, s + decay, NEG_INF)
        pr = jax.nn.softmax(s, axis=-1).astype(v.dtype)
        outs.append(jnp.einsum('bhqk,bkhd->bqhd', pr, v[:, :end]))
    return jnp.concatenate(outs, axis=1)


def sliding_window_attention(q, k, v, sinks, band_bias):
    Bn, S, _, d = q.shape
    nb = S // Q_BLOCK
    qb = q.reshape(Bn, nb, Q_BLOCK, D_KV_HEADS, D_GROUP, d)

    def band(t):
        tb = t.reshape(Bn, nb, Q_BLOCK, D_KV_HEADS, d)
        prev = jnp.concatenate([jnp.zeros_like(tb[:, :1]), tb[:, :-1]], axis=1)
        return jnp.concatenate([prev, tb], axis=2)

    kb, vb = band(k), band(v)
    s = jnp.einsum('bnqkgd,bnskd->bnkgqs', qb, kb).astype(jnp.float32) * d ** -0.5
    s = s + band_bias.reshape(D_KV_HEADS, D_GROUP, Q_BLOCK, 2 * Q_BLOCK)
    kj = jnp.arange(2 * Q_BLOCK)[None, :]
    dist = jnp.arange(Q_BLOCK)[:, None] + Q_BLOCK - kj
    in_window = (dist >= 0) & (dist < WINDOW)
    key_pos = jnp.arange(nb)[:, None] * Q_BLOCK - Q_BLOCK + kj
    valid = in_window[None] & (key_pos >= 0)[:, None, :]
    s = jnp.where(valid[None, :, None, None], s, NEG_INF)
    sink = sinks.astype(jnp.float32).reshape(1, 1, D_KV_HEADS, D_GROUP, 1, 1)
    m = jnp.maximum(jnp.max(s, axis=-1, keepdims=True), sink)
    e = jnp.exp(s - m)
    pr = (e / (jnp.sum(e, axis=-1, keepdims=True) + jnp.exp(sink - m))).astype(v.dtype)
    out = jnp.einsum('bnkgqs,bnskd->bnqkgd', pr, vb)
    return out.reshape(Bn, S, D_Q_HEADS * d)


def setup_inputs(seed: int = 0) -> dict:
    key = jax.random.key(seed)
    ks = iter(jax.random.split(key, 48))

    def nrm(shape, scale):
        return scale * jax.random.normal(next(ks), shape, jnp.float32)

    def gain(shape):
        return 1.0 + nrm(shape, 0.05)

    D, F = D_MODEL, D_FF
    return {
        'x': nrm((BATCH, SEQ, D), 1.0),
        'p': nrm((DEPTH, BATCH, SEQ, PLE_DIM), 1.0),
        'ffn1_norm_pre': gain((DEPTH, D)),
        'ffn1_w_gu': nrm((DEPTH, D, 2 * F), D ** -0.5),
        'ffn1_w_down': nrm((DEPTH, F, D), F ** -0.5),
        'ffn1_norm_post': gain((DEPTH, D)),
        'mix_norm_pre': gain((DEPTH, D)),
        'w_in': nrm((DEPTH, D, N_IN), D ** -0.5),
        'b_forget': 3.0 + nrm((DEPTH, A_HEADS), 1.0),
        'b_gate': nrm((DEPTH, N_BRANCH * D), 0.1),
        'conv_short': nrm((DEPTH, SHORT_CONV, B_WIDTH), SHORT_CONV ** -0.5),
        'conv_dw': nrm((DEPTH, CONF_CONV, C_WIDTH), CONF_CONV ** -0.5),
        'conv_dw_bias': nrm((DEPTH, C_WIDTH), 0.02),
        'conv_ln_gain': gain((DEPTH, C_WIDTH)),
        'conv_ln_bias': nrm((DEPTH, C_WIDTH), 0.02),
        'attn_sinks': nrm((DEPTH, D_Q_HEADS), 0.5),
        'rel_bias': nrm((REL_BUCKETS, D_Q_HEADS), 0.5),
        'w_br_a': nrm((DEPTH, A_WIDTH, D), A_WIDTH ** -0.5),
        'w_br_b': nrm((DEPTH, B_WIDTH, D), B_WIDTH ** -0.5),
        'w_br_c': nrm((DEPTH, C_WIDTH, D), C_WIDTH ** -0.5),
        'w_br_d': nrm((DEPTH, D_WIDTH, D), D_WIDTH ** -0.5),
        'w_o': nrm((DEPTH, D, D), D ** -0.5),
        'mix_norm_post': gain((DEPTH, D)),
        'ffn2_norm_pre': gain((DEPTH, D)),
        'ffn2_w_gu': nrm((DEPTH, D, 2 * F), D ** -0.5),
        'ffn2_w_down': nrm((DEPTH, F, D), F ** -0.5),
        'ffn2_norm_post': gain((DEPTH, D)),
        'ple_norm_gate': gain((DEPTH, D)),
        'w_ple_gate': nrm((DEPTH, D, D), D ** -0.5),
        'w_ple': nrm((DEPTH, PLE_DIM, D), PLE_DIM ** -0.5),
        'ple_norm_post': gain((DEPTH, D)),
    }


def reference(x, p, ffn1_norm_pre, ffn1_w_gu, ffn1_w_down, ffn1_norm_post,
              mix_norm_pre, w_in, b_forget, b_gate, conv_short, conv_dw, conv_dw_bias,
              conv_ln_gain, conv_ln_bias, attn_sinks, rel_bias,
              w_br_a, w_br_b, w_br_c, w_br_d, w_o, mix_norm_post,
              ffn2_norm_pre, ffn2_w_gu, ffn2_w_down, ffn2_norm_post,
              ple_norm_gate, w_ple_gate, w_ple, ple_norm_post):
    Bn, S, _ = x.shape
    band_dist = jnp.maximum(jnp.arange(Q_BLOCK)[:, None] + Q_BLOCK - jnp.arange(2 * Q_BLOCK)[None, :], 0)
    band_bias = jnp.transpose(rel_bias[t5_causal_bucket(band_dist)], (2, 0, 1)).astype(jnp.float32)

    h = x
    for i in range(DEPTH):
        f1 = swiglu_ffn(rms_norm(h, ffn1_norm_pre[i]), ffn1_w_gu[i], ffn1_w_down[i])
        h = h + 0.5 * rms_norm(f1, ffn1_norm_post[i])

        u = rms_norm(h, mix_norm_pre[i])
        proj = u @ w_in[i]
        a_qkv = proj[..., :A_QKV_END]
        a_f = proj[..., A_QKV_END:A_F_END]
        b_in = proj[..., A_F_END:B_END]
        c_in = proj[..., B_END:C_END]
        d_qkv = proj[..., C_END:D_END]
        gates = proj[..., D_END:]

        qa, ka, va = [t.reshape(Bn, S, A_HEADS, HEAD_DIM) for t in jnp.split(a_qkv, 3, axis=-1)]
        log_f = jax.nn.log_sigmoid(a_f.astype(jnp.float32) + b_forget[i].astype(jnp.float32))
        ya = forgetting_attention(qa, ka, va, log_f).reshape(Bn, S, A_WIDTH)

        bg, cg, xb = jnp.split(b_in, 3, axis=-1)
        yb = bg * causal_depthwise_conv(cg * xb, conv_short[i])

        glu = c_in[..., :C_WIDTH] * jax.nn.sigmoid(c_in[..., C_WIDTH:])
        yc = causal_depthwise_conv(glu, conv_dw[i]) + conv_dw_bias[i]
        yc = jax.nn.silu(layer_norm(yc, conv_ln_gain[i], conv_ln_bias[i]))

        qd = d_qkv[..., :D_WIDTH].reshape(Bn, S, D_Q_HEADS, HEAD_DIM)
        kd = d_qkv[..., D_WIDTH:D_WIDTH + D_KV_WIDTH].reshape(Bn, S, D_KV_HEADS, HEAD_DIM)
        vd = d_qkv[..., D_WIDTH + D_KV_WIDTH:].reshape(Bn, S, D_KV_HEADS, HEAD_DIM)
        yd = sliding_window_attention(qd, kd, vd, attn_sinks[i], band_bias)

        g = jax.nn.sigmoid(gates + b_gate[i]).reshape(Bn, S, N_BRANCH, D_MODEL)
        merged = (g[..., 0, :] * (ya @ w_br_a[i]) + g[..., 1, :] * (yb @ w_br_b[i])
                  + g[..., 2, :] * (yc @ w_br_c[i]) + g[..., 3, :] * (yd @ w_br_d[i]))
        h = h + rms_norm(merged @ w_o[i], mix_norm_post[i])

        f2 = swiglu_ffn(rms_norm(h, ffn2_norm_pre[i]), ffn2_w_gu[i], ffn2_w_down[i])
        h = h + 0.5 * rms_norm(f2, ffn2_norm_post[i])

        pg = jax.nn.sigmoid(rms_norm(h, ple_norm_gate[i]) @ w_ple_gate[i])
        h = h + pg * rms_norm(p[i] @ w_ple[i], ple_norm_post[i])
    return h
```

```cpp
#include <hip/hip_runtime.h>
#include <hip/hip_cooperative_groups.h>
#include <cstdio>
#include <cstdint>
#include <cmath>
namespace cg = cooperative_groups;

#ifndef MK_ONE_LAUNCH
#define MK_ONE_LAUNCH 1
#endif
namespace pg8 {
#define PG8_LAS __attribute__((address_space(3)))
typedef unsigned short bf16_t;
typedef short bf16x8 __attribute__((ext_vector_type(8)));
typedef float f32x4 __attribute__((ext_vector_type(4)));
typedef unsigned u32x4 __attribute__((ext_vector_type(4)));
constexpr int BM = 256, BK = 64, HALF = 128, HTB = HALF * BK * 2  , STAGE_BYTES = 8 * HTB, NXCD = 8, WGM = 8;

__host__ __device__ __forceinline__ int lds_byte(int r, int c) { const int st = (r >> 4) * 2 + (c >> 5), rr = r & 15, cc = c & 31, ob = rr * 64 + cc * 2; return st * 1024 + (ob ^ (((ob >> 9) & 1) << 5)); }
__host__ __device__ __forceinline__ void stage_rc(int b, int& R, int& C) { const int st = b / 1024, sb = b % 1024, swz = sb ^ (((sb >> 9) & 1) << 5); R = (st >> 1) * 16 + swz / 64; C = (st & 1) * 32 + (swz % 64) / 2; }
__host__ __device__ __forceinline__ int perm32(int rho) { const int n = rho >> 4, i = rho & 15; return 8 * (i >> 2) + 4 * n + (i & 3); }

struct Unit { int pm, pn; };
struct Gemm { const bf16_t* A; const bf16_t* Bt; int M, N, K; };

struct StaticOrder {
    int nM, nN, nwg, G, c;
    __host__ __device__ void init(int M, int N, int G_, int c_) { nM = M / BM; nN = N / BM; nwg = nM * nN; G = G_; c = c_; }
    __host__ __device__ bool next(int i, Unit& u) const {
        const long L = (long)i * G + c; if (L >= nwg) return false;
        int wgid = (int)L; { const int q = nwg / NXCD, r = nwg % NXCD, xcd = wgid % NXCD, off = wgid / NXCD; wgid = (xcd < r ? xcd * (q + 1) : r * (q + 1) + (xcd - r) * q) + off; }
        const int nig = WGM * nN, gid = wgid / nig, fm = gid * WGM, gsz = (nM - fm) < WGM ? (nM - fm) : WGM;
        u.pm = fm + ((wgid % nig) % gsz); u.pn = (wgid % nig) / gsz; return true;
    }
    __device__ __forceinline__ void a_ready(const Unit&) const {}
    __device__ __forceinline__ void done(const Unit&) const {}
};

__device__ __forceinline__ unsigned cvt_pk_bf16(float lo, float hi) { unsigned r; asm volatile("v_cvt_pk_bf16_f32 %0, %1, %2" : "=v"(r) : "v"(lo), "v"(hi)); return r; }
typedef float f32x2 __attribute__((ext_vector_type(2)));

__device__ __forceinline__ float bf2f(unsigned short v) { return __uint_as_float(((unsigned)v) << 16); }
__device__ __forceinline__ float bflo(unsigned w) { return __uint_as_float(w << 16); }
__device__ __forceinline__ float bfhi(unsigned w) { return __uint_as_float(w & 0xffff0000u); }
__device__ __forceinline__ float sigmoid_f(float x) { return __builtin_amdgcn_rcpf(1.0f + __builtin_amdgcn_exp2f(-1.4426950408889634f * x)); }

struct EpiSwiglu {
    static constexpr bool PERM = true, AFTER_DRAIN = false, HOOK = false;
    bf16_t* O; int ldc;
    __device__ __forceinline__ void operator()(const f32x4 (&acc)[2][2][4][2], const Unit& u, int wr, int wc, int fr, int fq) const {
        const int row0 = u.pm * BM + wr * 64 + fr, col0 = u.pn * HALF + wc * 32 + 8 * fq;
#pragma unroll
        for (int ai = 0; ai < 2; ++ai)
#pragma unroll
            for (int m = 0; m < 4; ++m) {
                bf16_t* rowp = O + (size_t)(row0 + ai * HALF + m * 16) * ldc + col0;
                float v[8];
#pragma unroll
                for (int n = 0; n < 2; ++n)
#pragma unroll
                    for (int e = 0; e < 4; ++e) { const float g = acc[ai][0][m][n][e], up = acc[ai][1][m][n][e]; v[4 * n + e] = g * sigmoid_f(g) * up; }
                u32x4 w; w.x = cvt_pk_bf16(v[0], v[1]); w.y = cvt_pk_bf16(v[2], v[3]); w.z = cvt_pk_bf16(v[4], v[5]); w.w = cvt_pk_bf16(v[6], v[7]);
                __builtin_nontemporal_store(w, (u32x4*)rowp);
            }
    }
};
struct EpiF32 {
    static constexpr bool PERM = false, AFTER_DRAIN = false, HOOK = false;
    float* O; int ldc;
    __device__ __forceinline__ void operator()(const f32x4 (&acc)[2][2][4][2], const Unit& u, int wr, int wc, int fr, int fq) const {
        const int row0 = u.pm * BM + wr * 64 + fr, col0 = u.pn * BM + wc * 32 + 4 * fq;
#pragma unroll
        for (int ai = 0; ai < 2; ++ai)
#pragma unroll
            for (int m = 0; m < 4; ++m) {
                float* rowp = O + (size_t)(row0 + ai * HALF + m * 16) * ldc + col0;
#pragma unroll
                for (int bj = 0; bj < 2; ++bj)
#pragma unroll
                    for (int n = 0; n < 2; ++n) *(f32x4*)(rowp + bj * HALF + n * 16) = acc[ai][bj][m][n];
            }
    }
};
struct EpiBf16 {
    static constexpr bool PERM = true, AFTER_DRAIN = false, HOOK = false;
    bf16_t* O; int ldc;
    __device__ __forceinline__ void operator()(const f32x4 (&acc)[2][2][4][2], const Unit& u, int wr, int wc, int fr, int fq) const {
        const int row0 = u.pm * BM + wr * 64 + fr, col0 = u.pn * BM + wc * 32 + 8 * fq;
#pragma unroll
        for (int ai = 0; ai < 2; ++ai)
#pragma unroll
            for (int m = 0; m < 4; ++m) {
                bf16_t* rowp = O + (size_t)(row0 + ai * HALF + m * 16) * ldc + col0;
#pragma unroll
                for (int bj = 0; bj < 2; ++bj) {
                    const f32x4 v0 = acc[ai][bj][m][0], v1 = acc[ai][bj][m][1];
                    u32x4 w; w.x = cvt_pk_bf16(v0[0], v0[1]); w.y = cvt_pk_bf16(v0[2], v0[3]); w.z = cvt_pk_bf16(v1[0], v1[1]); w.w = cvt_pk_bf16(v1[2], v1[3]);
                    *(u32x4*)(rowp + bj * HALF) = w;
                }
            }
    }
};
struct EpiProj {
    static constexpr bool PERM = true, AFTER_DRAIN = false, HOOK = false;
    bf16_t* O; int ldc; const float* bgate; float qscale;
    __device__ __forceinline__ void operator()(const f32x4 (&acc)[2][2][4][2], const Unit& u, int wr, int wc, int fr, int fq) const {
        const int row0 = u.pm * BM + wr * 64 + fr, col0 = u.pn * BM + wc * 32 + 8 * fq;
        const bool isgate = u.pn >= 11; const float sc = (u.pn == 0 || u.pn == 8 || u.pn == 9) ? qscale : 1.0f;
        f32x4 bv[2][2];
#pragma unroll
        for (int bj = 0; bj < 2; ++bj)
#pragma unroll
            for (int n = 0; n < 2; ++n) bv[bj][n] = isgate ? *(const f32x4*)(bgate + (col0 - 2816) + bj * HALF + 4 * n) : (f32x4){0.f, 0.f, 0.f, 0.f};
#pragma unroll
        for (int ai = 0; ai < 2; ++ai)
#pragma unroll
            for (int m = 0; m < 4; ++m) {
                bf16_t* rowp = O + (size_t)(row0 + ai * HALF + m * 16) * ldc + col0;
#pragma unroll
                for (int bj = 0; bj < 2; ++bj) {
                    f32x4 v0 = acc[ai][bj][m][0], v1 = acc[ai][bj][m][1];
                    if (isgate) {
                        v0 = v0 + bv[bj][0]; v1 = v1 + bv[bj][1];
#pragma unroll
                        for (int e = 0; e < 4; ++e) { v0[e] = fmaxf(sigmoid_f(v0[e]), 1e-6f); v1[e] = fmaxf(sigmoid_f(v1[e]), 1e-6f); }
                    } else { v0 = v0 * sc; v1 = v1 * sc; }
                    u32x4 w; w.x = cvt_pk_bf16(v0[0], v0[1]); w.y = cvt_pk_bf16(v0[2], v0[3]); w.z = cvt_pk_bf16(v1[0], v1[1]); w.w = cvt_pk_bf16(v1[2], v1[3]);
                    __builtin_nontemporal_store(w, (u32x4*)(rowp + bj * HALF));
                }
            }
    }
};
struct EpiMerge {
    static constexpr bool PERM = true, AFTER_DRAIN = false, HOOK = true;
    bf16_t* O; int ldc; const bf16_t* G; int ldg;
    __device__ __forceinline__ void hook(f32x4 (&acc)[2][2][4][2], const Unit& u, int br, int wr, int wc, int fr, int fq) const {
        const int row0 = u.pm * BM + wr * 64 + fr, col0 = u.pn * BM + wc * 32 + 8 * fq;
#pragma unroll
        for (int ai = 0; ai < 2; ++ai) {
            u32x4 gc[4][2], gq[4][2];
#pragma unroll
            for (int m = 0; m < 4; ++m) {
                const bf16_t* gp = G + (size_t)(row0 + ai * HALF + m * 16) * ldg + col0 + 1024 * br;
#pragma unroll
                for (int bj = 0; bj < 2; ++bj) { gc[m][bj] = *(const u32x4*)(gp + bj * HALF); gq[m][bj] = *(const u32x4*)(gp + bj * HALF - 1024); }
            }
#pragma unroll
            for (int m = 0; m < 4; ++m)
#pragma unroll
                for (int bj = 0; bj < 2; ++bj) {
                    const u32x4 c = gc[m][bj], q = gq[m][bj];
                    f32x4 r0, r1;
                    r0[0] = bflo(q.x) * __builtin_amdgcn_rcpf(bflo(c.x)); r0[1] = bfhi(q.x) * __builtin_amdgcn_rcpf(bfhi(c.x));
                    r0[2] = bflo(q.y) * __builtin_amdgcn_rcpf(bflo(c.y)); r0[3] = bfhi(q.y) * __builtin_amdgcn_rcpf(bfhi(c.y));
                    r1[0] = bflo(q.z) * __builtin_amdgcn_rcpf(bflo(c.z)); r1[1] = bfhi(q.z) * __builtin_amdgcn_rcpf(bfhi(c.z));
                    r1[2] = bflo(q.w) * __builtin_amdgcn_rcpf(bflo(c.w)); r1[3] = bfhi(q.w) * __builtin_amdgcn_rcpf(bfhi(c.w));
                    acc[ai][bj][m][0] = acc[ai][bj][m][0] * r0; acc[ai][bj][m][1] = acc[ai][bj][m][1] * r1;
                }
            asm volatile("" ::: "memory");
        }
    }
    __device__ __forceinline__ void operator()(const f32x4 (&acc)[2][2][4][2], const Unit& u, int wr, int wc, int fr, int fq) const {
        const int row0 = u.pm * BM + wr * 64 + fr, col0 = u.pn * BM + wc * 32 + 8 * fq;
#pragma unroll
        for (int ai = 0; ai < 2; ++ai) {
            u32x4 gc[4][2];
#pragma unroll
            for (int m = 0; m < 4; ++m)
#pragma unroll
                for (int bj = 0; bj < 2; ++bj) gc[m][bj] = *(const u32x4*)(G + (size_t)(row0 + ai * HALF + m * 16) * ldg + col0 + 3072 + bj * HALF);
#pragma unroll
            for (int m = 0; m < 4; ++m) {
                bf16_t* rowp = O + (size_t)(row0 + ai * HALF + m * 16) * ldc + col0;
#pragma unroll
                for (int bj = 0; bj < 2; ++bj) {
                    const u32x4 c = gc[m][bj];
                    const f32x4 a0 = acc[ai][bj][m][0], a1 = acc[ai][bj][m][1];
                    u32x4 w; w.x = cvt_pk_bf16(a0[0] * bflo(c.x), a0[1] * bfhi(c.x)); w.y = cvt_pk_bf16(a0[2] * bflo(c.y), a0[3] * bfhi(c.y));
                    w.z = cvt_pk_bf16(a1[0] * bflo(c.z), a1[1] * bfhi(c.z)); w.w = cvt_pk_bf16(a1[2] * bflo(c.w), a1[3] * bfhi(c.w));
                    *(u32x4*)(rowp + bj * HALF) = w;
                }
            }
            asm volatile("" ::: "memory");
        }
    }
};
template <class Epi, class Sched, bool ALIGN_EPI = false, bool SP2 = false>
__device__ __forceinline__ void gemm_phase(PG8_LAS unsigned char* lds, const Gemm g, const Sched& S, const Epi& E) {
    int tid_ = threadIdx.x; asm volatile("" : "+v"(tid_));
    const int tid = tid_, wid = __builtin_amdgcn_readfirstlane(tid >> 6), lane = tid & 63, wr = wid >> 2, wc = wid & 3, fr = lane & 15, fq = lane >> 4;
    const int K = g.K, nt = K / BK;
    unsigned voffA[2], voffB[2];
#pragma unroll
    for (int i = 0; i < 2; ++i) { int R, C; stage_rc(tid * 16 + i * 8192, R, C); const int Rb = Epi::PERM ? ((R & ~31) + perm32(R & 31)) : R;
        voffA[i] = (unsigned)(R * K + C) * 2u; voffB[i] = (unsigned)(Rb * K + C) * 2u; }
    const size_t kstep = (size_t)(BK * 2);
    const size_t hstep = (size_t)HALF * K * 2;
    const size_t tstep = 2 * hstep;
    const unsigned ldsw = (unsigned)wid * 1024u;
    const int aoff = lds_byte(wr * 64 + fr, fq * 8), boff = lds_byte(wc * 32 + fr, fq * 8);
#define PG8_SA(b, h) (((b) * 2 + (h)) * HTB)
#define PG8_SB(b, h) ((4 + (b) * 2 + (h)) * HTB)
#define PG8_STAGE(bufoff, gbase, voff) do { _Pragma("unroll") for (int _i = 0; _i < 2; ++_i) \
        __builtin_amdgcn_global_load_lds((const unsigned*)((const char*)(gbase) + (voff)[_i]), (PG8_LAS unsigned*)(lds + (bufoff) + ldsw + _i * 8192), 16, 0, 0); } while (0)
#define PG8_LDA(dst, b, h) do { _Pragma("unroll") for (int m = 0; m < 4; ++m) _Pragma("unroll") for (int k = 0; k < 2; ++k) dst[m][k] = *(const PG8_LAS bf16x8*)(lds + PG8_SA(b, h) + aoff + m * 2048 + k * 1024); } while (0)
#define PG8_LDB(dst, b, h) do { _Pragma("unroll") for (int n = 0; n < 2; ++n) _Pragma("unroll") for (int k = 0; k < 2; ++k) dst[n][k] = *(const PG8_LAS bf16x8*)(lds + PG8_SB(b, h) + boff + n * 2048 + k * 1024); } while (0)
#define PG8_MMA(ai, bj, At, Bt) do { __builtin_amdgcn_s_setprio(1); _Pragma("unroll") for (int m = 0; m < 4; ++m) _Pragma("unroll") for (int n = 0; n < 2; ++n) _Pragma("unroll") for (int k = 0; k < 2; ++k) \
        acc[ai][bj][m][n] = __builtin_amdgcn_mfma_f32_16x16x32_bf16(Bt[n][k], At[m][k], acc[ai][bj][m][n], 0, 0, 0); __builtin_amdgcn_s_setprio(0); } while (0)
#define PG8_WAIT_V(n) asm volatile("s_waitcnt vmcnt(" #n ")" ::: "memory")
#define PG8_WAIT_L(n) asm volatile("s_waitcnt lgkmcnt(" #n ")" ::: "memory")
#define PG8_BAR __builtin_amdgcn_s_barrier()
#define PG8_SCHED __builtin_amdgcn_sched_barrier(0)
    Unit cur, nxt; int ui = 0;
    if (!S.next(0, cur)) return;
    f32x4 acc[2][2][4][2];
#pragma unroll
    for (int a = 0; a < 2; ++a)
#pragma unroll
        for (int b = 0; b < 2; ++b)
#pragma unroll
            for (int m = 0; m < 4; ++m)
#pragma unroll
                for (int n = 0; n < 2; ++n) acc[a][b][m][n] = (f32x4){0.f, 0.f, 0.f, 0.f};
    bf16x8 At[4][2], B0[2][2], B1[2][2];
    const char* cA = (const char*)g.A + (size_t)cur.pm * tstep; const char* cB = (const char*)g.Bt + (size_t)cur.pn * tstep;
    S.a_ready(cur);
    if constexpr (SP2) {
        PG8_STAGE(PG8_SB(0, 0), cB, voffB); PG8_STAGE(PG8_SB(0, 1), cB + hstep, voffB); PG8_STAGE(PG8_SA(0, 0), cA, voffA); PG8_STAGE(PG8_SA(0, 1), cA + hstep, voffA);
        if (wr == 1) PG8_BAR;
        PG8_WAIT_V(2); PG8_BAR;
        PG8_STAGE(PG8_SB(1, 0), cB + kstep, voffB); PG8_STAGE(PG8_SA(1, 0), cA + kstep, voffA); PG8_STAGE(PG8_SB(1, 1), cB + hstep + kstep, voffB);
        PG8_WAIT_V(6); PG8_BAR;
    } else {
        PG8_STAGE(PG8_SB(0, 0), cB, voffB); PG8_STAGE(PG8_SA(0, 0), cA, voffA); PG8_STAGE(PG8_SB(0, 1), cB + hstep, voffB); PG8_STAGE(PG8_SA(0, 1), cA + hstep, voffA);
        if (wr == 1) PG8_BAR;
        PG8_WAIT_V(4); PG8_BAR;
        PG8_STAGE(PG8_SB(1, 0), cB + kstep, voffB); PG8_STAGE(PG8_SA(1, 0), cA + kstep, voffA); PG8_STAGE(PG8_SB(1, 1), cB + hstep + kstep, voffB);
        PG8_WAIT_V(6); PG8_BAR;
    }
    for (;;) {
        const bool has_next = S.next(ui + 1, nxt);
        const char* nA = has_next ? (const char*)g.A + (size_t)nxt.pm * tstep : cA; const char* nB = has_next ? (const char*)g.Bt + (size_t)nxt.pn * tstep : cB;
        for (int t = 0; t < nt; t += 2) {
            if constexpr (Epi::HOOK) { if (t == 4 || t == 8 || t == 12) E.hook(acc, cur, t >> 2, wr, wc, fr, fq); }
            const bool last = (t == nt - 2);
            const char* a1 = cA + (size_t)(t + 1) * kstep;
            const char* a2 = last ? nA : cA + (size_t)(t + 2) * kstep; const char* b2 = last ? nB : cB + (size_t)(t + 2) * kstep;
            const char* a3 = a2 + kstep; const char* b3 = b2 + kstep;
            if (last && has_next) S.a_ready(nxt);
            if constexpr (SP2) {
            PG8_LDB(B0, 0, 0); PG8_LDB(B1, 0, 1); PG8_SCHED; PG8_LDA(At, 0, 0); PG8_STAGE(PG8_SA(1, 1), a1 + hstep, voffA);
            PG8_WAIT_V(8); PG8_WAIT_L(0); PG8_BAR; PG8_MMA(0, 0, At, B0); PG8_MMA(0, 1, At, B1); PG8_BAR; PG8_SCHED;
            PG8_LDA(At, 0, 1); PG8_STAGE(PG8_SB(0, 0), b2, voffB); PG8_STAGE(PG8_SB(0, 1), b2 + hstep, voffB); PG8_STAGE(PG8_SA(0, 0), a2, voffA);
            PG8_WAIT_V(8); PG8_WAIT_L(0); PG8_BAR; PG8_MMA(1, 0, At, B0); PG8_MMA(1, 1, At, B1); PG8_BAR; PG8_SCHED;
            PG8_LDB(B0, 1, 0); PG8_LDB(B1, 1, 1); PG8_SCHED; PG8_LDA(At, 1, 0); PG8_STAGE(PG8_SA(0, 1), a2 + hstep, voffA);
            PG8_WAIT_V(8); PG8_WAIT_L(0); PG8_BAR; PG8_MMA(0, 0, At, B0); PG8_MMA(0, 1, At, B1); PG8_BAR; PG8_SCHED;
            PG8_LDA(At, 1, 1); PG8_STAGE(PG8_SB(1, 0), b3, voffB); PG8_STAGE(PG8_SB(1, 1), b3 + hstep, voffB); PG8_STAGE(PG8_SA(1, 0), a3, voffA);
            PG8_WAIT_V(8); PG8_WAIT_L(0); PG8_BAR; PG8_MMA(1, 0, At, B0); PG8_MMA(1, 1, At, B1); PG8_BAR; PG8_SCHED;
            } else {
            PG8_LDB(B0, 0, 0); PG8_SCHED; PG8_LDA(At, 0, 0); PG8_STAGE(PG8_SA(1, 1), a1 + hstep, voffA);
            PG8_WAIT_L(8); PG8_BAR; PG8_WAIT_L(0); PG8_MMA(0, 0, At, B0); PG8_BAR; PG8_SCHED;
            PG8_LDB(B1, 0, 1); PG8_STAGE(PG8_SB(0, 0), b2, voffB);
            PG8_BAR; PG8_WAIT_L(0); PG8_MMA(0, 1, At, B1); PG8_BAR;
            PG8_LDA(At, 0, 1); PG8_STAGE(PG8_SA(0, 0), a2, voffA);
            PG8_BAR; PG8_WAIT_L(0); PG8_MMA(1, 0, At, B0); PG8_BAR; PG8_SCHED;
            PG8_STAGE(PG8_SB(0, 1), b2 + hstep, voffB);
            PG8_WAIT_V(6); PG8_BAR; PG8_MMA(1, 1, At, B1); PG8_BAR;
            PG8_LDB(B0, 1, 0); PG8_SCHED; PG8_LDA(At, 1, 0); PG8_STAGE(PG8_SA(0, 1), a2 + hstep, voffA);
            PG8_WAIT_L(8); PG8_BAR; PG8_WAIT_L(0); PG8_MMA(0, 0, At, B0); PG8_BAR; PG8_SCHED;
            PG8_LDB(B1, 1, 1); PG8_STAGE(PG8_SB(1, 0), b3, voffB);
            PG8_BAR; PG8_WAIT_L(0); PG8_MMA(0, 1, At, B1); PG8_BAR;
            PG8_LDA(At, 1, 1); PG8_STAGE(PG8_SA(1, 0), a3, voffA);
            PG8_BAR; PG8_WAIT_L(0); PG8_MMA(1, 0, At, B0); PG8_BAR; PG8_SCHED;
            PG8_STAGE(PG8_SB(1, 1), b3 + hstep, voffB);
            PG8_WAIT_V(6); PG8_BAR; PG8_MMA(1, 1, At, B1); PG8_BAR;
            }
        }
        if constexpr (ALIGN_EPI) { if (wr == 0) PG8_BAR; }
        if constexpr (!Epi::AFTER_DRAIN) { E(acc, cur, wr, wc, fr, fq); S.done(cur); }
        if (!has_next) break;
#pragma unroll
        for (int a = 0; a < 2; ++a)
#pragma unroll
            for (int b = 0; b < 2; ++b)
#pragma unroll
                for (int m = 0; m < 4; ++m)
#pragma unroll
                    for (int n = 0; n < 2; ++n) acc[a][b][m][n] = (f32x4){0.f, 0.f, 0.f, 0.f};
        cur = nxt; cA = nA; cB = nB; ++ui;
        if constexpr (ALIGN_EPI) { if (wr == 1) PG8_BAR; }
    }
    PG8_WAIT_V(0);
    if constexpr (!ALIGN_EPI) { if (wr == 0) PG8_BAR; }
    PG8_BAR;
    if constexpr (Epi::AFTER_DRAIN) { E.fused(acc, cur, wr, wc, fr, fq, lds, wid, lane); S.done(cur); }
#undef PG8_SA
#undef PG8_SB
#undef PG8_STAGE
#undef PG8_LDA
#undef PG8_LDB
#undef PG8_MMA
#undef PG8_WAIT_V
#undef PG8_WAIT_L
#undef PG8_BAR
#undef PG8_SCHED
}
}

#define LAS __attribute__((address_space(3)))
typedef unsigned short bf16_t;
typedef short bf16x8 __attribute__((ext_vector_type(8)));
typedef float f32x4 __attribute__((ext_vector_type(4)));
typedef float f32x16 __attribute__((ext_vector_type(16)));
typedef unsigned u32x4 __attribute__((ext_vector_type(4)));
typedef unsigned u32x2 __attribute__((ext_vector_type(2)));
using pg8::bflo; using pg8::bfhi; using pg8::sigmoid_f; using pg8::cvt_pk_bf16;

constexpr int DM = 1024, NB = 32, SEQ = 2048, DEPTH = 4, M = NB * SEQ, FF = 2816, NIN = 6916, NPROJ = 6912, PLE = 256, YW = 1280;
constexpr int MH = M / 2;
constexpr float EPS = 1e-6f, LOG2E = 1.4426950408889634f, QSCALE = 0.125f * 1.4426950408889634f, NEGBIG = -1e30f;
constexpr int NWAVES = 8, NTHREADS = 512;
constexpr int LDS_BYTES = 147456;
constexpr int PH_PER_LAYER = 17, N_PHASES = PH_PER_LAYER * DEPTH;

constexpr size_t MiB = 1u << 20;
constexpr size_t WS_W = 1 * MiB, WS_CTL_BAR = 16384, CTL_ZERO_BYTES = 65536;
constexpr size_t W_GU1 = WS_W, W_D1 = W_GU1 + (size_t)2 * FF * DM * 2, W_IN = W_D1 + (size_t)DM * FF * 2, W_BR = W_IN + (size_t)NPROJ * DM * 2, W_O = W_BR + (size_t)DM * YW * 2,
                 W_GU2 = W_O + (size_t)DM * DM * 2, W_D2 = W_GU2 + (size_t)2 * FF * DM * 2, W_PG = W_D2 + (size_t)DM * FF * 2, W_PLE = W_PG + (size_t)DM * DM * 2, W_AF = W_PLE + (size_t)DM * PLE * 2, W_END = W_AF + 16384;
static_assert(W_END <= 58 * MiB, "weights region");
constexpr size_t WS_U = 64 * MiB, WS_HID = 192 * MiB, WS_F = 544 * MiB, WS_PROJ = 192 * MiB, WS_YCAT = 624 * MiB, WS_MERGED = 800 * MiB, WS_LOGF = 928 * MiB, WS_CUM = 929 * MiB, WS_PBF = 930 * MiB, WS_F2 = 192 * MiB, WS_WB = 962 * MiB, WS_NEED = 1020 * MiB;
static_assert(WS_PROJ + (size_t)MH * NPROJ * 2 <= WS_YCAT && WS_YCAT + (size_t)M * YW * 2 <= WS_MERGED && WS_MERGED + (size_t)M * DM * 2 <= WS_LOGF && WS_HID + (size_t)M * FF * 2 <= WS_F && WS_F + (size_t)M * DM * 4 <= WS_MERGED && WS_PBF + (size_t)M * PLE * 2 <= WS_NEED && WS_F2 + (size_t)M * DM * 4 <= WS_F, "ws map");

#define CAS __attribute__((address_space(4)))
struct Args { const float* in[31]; float* out; unsigned char* ws; int ph_lo, ph_hi; unsigned char bucket[128]; };

template <int CTRL> __device__ __forceinline__ float dpp_f(float v) { return __builtin_bit_cast(float, __builtin_amdgcn_update_dpp(0, __builtin_bit_cast(int, v), CTRL, 0xf, 0xf, false)); }
__device__ __forceinline__ float wave_sum(float v) {
    v += dpp_f<0xB1>(v);
    v += dpp_f<0x4E>(v);
    v += dpp_f<0x141>(v);
    v += dpp_f<0x140>(v);
    const int b = __builtin_bit_cast(int, v);
    const float r0 = __builtin_bit_cast(float, __builtin_amdgcn_readlane(b, 0)), r1 = __builtin_bit_cast(float, __builtin_amdgcn_readlane(b, 16));
    const float r2 = __builtin_bit_cast(float, __builtin_amdgcn_readlane(b, 32)), r3 = __builtin_bit_cast(float, __builtin_amdgcn_readlane(b, 48));
    return (r0 + r1) + (r2 + r3);
}
__device__ __forceinline__ unsigned f2bf(float f) { unsigned u = __builtin_bit_cast(unsigned, f); return (u + 0x7fffu + ((u >> 16) & 1u)) >> 16; }
__device__ __forceinline__ unsigned pk2(float lo, float hi) { return f2bf(lo) | (f2bf(hi) << 16); }

__device__ __forceinline__ void transpose_item(const float* W, int ldn, int k0, int src_col0, bf16_t* WT, int ldk, int dst_row0, int dst_k0, LAS float* scr, int lane) {
#pragma unroll 16
    for (int i = 0; i < 32; ++i) { const int kk = 2 * i + (lane >> 5); scr[kk * 33 + (lane & 31)] = W[(size_t)(k0 + kk) * ldn + src_col0 + (lane & 31)]; }
    asm volatile("s_waitcnt lgkmcnt(0)" ::: "memory");
    const int c = lane & 7;
#pragma unroll
    for (int j = 0; j < 4; ++j) { const int n = (lane >> 3) + 8 * j; const LAS float* s = scr + (8 * c) * 33 + n;
        u32x4 o; o.x = pk2(s[0 * 33], s[1 * 33]); o.y = pk2(s[2 * 33], s[3 * 33]); o.z = pk2(s[4 * 33], s[5 * 33]); o.w = pk2(s[6 * 33], s[7 * 33]);
        *(u32x4*)(WT + (size_t)(dst_row0 + n) * ldk + dst_k0 + 8 * c) = o; }
    asm volatile("s_waitcnt lgkmcnt(0)" ::: "memory");
}
__device__ __forceinline__ void transpose_matrix_item(const float* W, int K, int ldn, int Ndst, int mode, bf16_t* WT, int ldk, int dst_k0, LAS float* scr, int item, int lane) {
    const int nnb = Ndst / 32, kb = item / nnb, nb = item % nnb, n0 = nb * 32;
    int src;
    if (mode == 1) { const int t = n0 >> 8, r = n0 & 255; src = (r < 128) ? (128 * t + r) : (FF + 128 * t + (r - 128)); }
    else if (mode == 2) src = n0 + (n0 >= 768 ? 4 : 0);
    else src = n0;
    transpose_item(W, ldn, kb * 64, src, WT, ldk, n0, dst_k0 + kb * 64, scr, lane);
}
__device__ __forceinline__ void wconv_phase(const CAS Args* a, int L, int part, LAS unsigned char* lds, int gw, int NGW, int wave, int lane) {
    LAS float* scr = (LAS float*)(lds + wave * 16384);
    unsigned char* ws = a->ws + ((L & 1) ? WS_WB - WS_W : 0);
    const float* gu1 = a->in[3] + (size_t)L * DM * 2 * FF; const float* d1 = a->in[4] + (size_t)L * FF * DM; const float* win = a->in[7] + (size_t)L * DM * NIN;
    const float* bra = a->in[17] + (size_t)L * 256 * DM; const float* brb = a->in[18] + (size_t)L * 256 * DM; const float* brc = a->in[19] + (size_t)L * 256 * DM; const float* brd = a->in[20] + (size_t)L * 512 * DM;
    const float* wo = a->in[21] + (size_t)L * DM * DM; const float* gu2 = a->in[24] + (size_t)L * DM * 2 * FF; const float* d2 = a->in[25] + (size_t)L * FF * DM;
    const float* wpg = a->in[28] + (size_t)L * DM * DM; const float* wple = a->in[29] + (size_t)L * PLE * DM;
    constexpr int I_GU = (DM / 64) * (2 * FF / 32), I_D = (FF / 64) * (DM / 32), I_IN = (DM / 64) * (NPROJ / 32), I_BR = (256 / 64) * (DM / 32), I_BRD = (512 / 64) * (DM / 32), I_SQ = (DM / 64) * (DM / 32), I_PLE = (PLE / 64) * (DM / 32);
    constexpr int NITEMS = 2 * I_GU + 2 * I_D + I_IN + 3 * I_BR + I_BRD + 2 * I_SQ + I_PLE;
    const int it_lo = (part == 1) ? NITEMS / 2 : 0, it_hi = (part == 0) ? NITEMS / 2 : NITEMS;
    for (int it = it_lo + gw; it < it_hi; it += NGW) {
        int r = it;
        if (r < I_GU) { transpose_matrix_item(gu1, DM, 2 * FF, 2 * FF, 1, (bf16_t*)(ws + W_GU1), DM, 0, scr, r, lane); continue; } r -= I_GU;
        if (r < I_GU) { transpose_matrix_item(gu2, DM, 2 * FF, 2 * FF, 1, (bf16_t*)(ws + W_GU2), DM, 0, scr, r, lane); continue; } r -= I_GU;
        if (r < I_D) { transpose_matrix_item(d1, FF, DM, DM, 0, (bf16_t*)(ws + W_D1), FF, 0, scr, r, lane); continue; } r -= I_D;
        if (r < I_D) { transpose_matrix_item(d2, FF, DM, DM, 0, (bf16_t*)(ws + W_D2), FF, 0, scr, r, lane); continue; } r -= I_D;
        if (r < I_IN) { transpose_matrix_item(win, DM, NIN, NPROJ, 2, (bf16_t*)(ws + W_IN), DM, 0, scr, r, lane); continue; } r -= I_IN;
        if (r < I_BR) { transpose_matrix_item(bra, 256, DM, DM, 0, (bf16_t*)(ws + W_BR), YW, 0, scr, r, lane); continue; } r -= I_BR;
        if (r < I_BR) { transpose_matrix_item(brb, 256, DM, DM, 0, (bf16_t*)(ws + W_BR), YW, 256, scr, r, lane); continue; } r -= I_BR;
        if (r < I_BR) { transpose_matrix_item(brc, 256, DM, DM, 0, (bf16_t*)(ws + W_BR), YW, 512, scr, r, lane); continue; } r -= I_BR;
        if (r < I_BRD) { transpose_matrix_item(brd, 512, DM, DM, 0, (bf16_t*)(ws + W_BR), YW, 768, scr, r, lane); continue; } r -= I_BRD;
        if (r < I_SQ) { transpose_matrix_item(wo, DM, DM, DM, 0, (bf16_t*)(ws + W_O), DM, 0, scr, r, lane); continue; } r -= I_SQ;
        if (r < I_SQ) { transpose_matrix_item(wpg, DM, DM, DM, 0, (bf16_t*)(ws + W_PG), DM, 0, scr, r, lane); continue; } r -= I_SQ;
        transpose_matrix_item(wple, PLE, DM, DM, 0, (bf16_t*)(ws + W_PLE), PLE, 0, scr, r, lane);
    }
    float* af = (float*)(ws + W_AF);
    if (part != 1) for (int i = gw * 64 + lane; i < DM * 4; i += NGW * 64) af[i] = win[(size_t)(i >> 2) * NIN + 768 + (i & 3)];
}

__device__ __forceinline__ float log_sigmoid_f(float x) { return fminf(x, 0.f) - log1pf(expf(-fabsf(x))); }
typedef _Float16 h16x2 __attribute__((ext_vector_type(2)));
__device__ __forceinline__ unsigned pkh(float a, float b) { h16x2 v; v.x = (_Float16)a; v.y = (_Float16)b; return __builtin_bit_cast(unsigned, v); }
__device__ __forceinline__ float hlo(unsigned w) { return (float)__builtin_bit_cast(h16x2, w).x; }
__device__ __forceinline__ float hhi(unsigned w) { return (float)__builtin_bit_cast(h16x2, w).y; }
struct RowArgs { const float* hin32; const unsigned short* hin16; float* hout32; unsigned short* hout16; const bf16_t* F; const bf16_t* F2; const float* gpost; float scale; const float* gnext; bf16_t* U; const float* AF; const float* bforget; float* LOGF; const float* p; bf16_t* Pbf; };
struct RowRaw { f32x4 v32[2][2]; u32x4 v16[2]; u32x4 f[2]; u32x4 e[2]; f32x4 p; };
__device__ __forceinline__ void row_load(const RowArgs& R, int m, int lane, RowRaw& q) {
    const size_t off = (size_t)m * DM + 8 * lane;
    if (R.hin32) {
#pragma unroll
        for (int j = 0; j < 2; ++j) { q.v32[j][0] = __builtin_nontemporal_load((const f32x4*)(R.hin32 + off + 512 * j)); q.v32[j][1] = __builtin_nontemporal_load((const f32x4*)(R.hin32 + off + 512 * j + 4)); }
    } else {
#pragma unroll
        for (int j = 0; j < 2; ++j) q.v16[j] = __builtin_nontemporal_load((const u32x4*)(R.hin16 + off + 512 * j));
    }
    if (R.F) {
#pragma unroll
        for (int j = 0; j < 2; ++j) q.f[j] = __builtin_nontemporal_load((const u32x4*)(R.F + off + 512 * j));
    }
    if (R.F2) {
#pragma unroll
        for (int j = 0; j < 2; ++j) q.e[j] = __builtin_nontemporal_load((const u32x4*)(R.F2 + off + 512 * j));
    }
    if (R.p) q.p = __builtin_nontemporal_load((const f32x4*)(R.p + (size_t)m * PLE + 4 * lane));
}
#define UNPK_BF(dst, SRC_) do { const u32x4 t_ = (SRC_); dst[0] = bflo(t_.x); dst[1] = bfhi(t_.x); dst[2] = bflo(t_.y); dst[3] = bfhi(t_.y); dst[4] = bflo(t_.z); dst[5] = bfhi(t_.z); dst[6] = bflo(t_.w); dst[7] = bfhi(t_.w); } while (0)
__device__ __forceinline__ void row_process(const RowArgs& R, int m, int lane, const RowRaw& q, const float (&gp)[2][8], const float (&gn)[2][8], const f32x4 bf) {
    const size_t off = (size_t)m * DM + 8 * lane;
    float v[2][8];
    if (R.hin32) {
#pragma unroll
        for (int j = 0; j < 2; ++j)
#pragma unroll
            for (int e = 0; e < 4; ++e) { v[j][e] = q.v32[j][0][e]; v[j][4 + e] = q.v32[j][1][e]; }
    } else {
#pragma unroll
        for (int j = 0; j < 2; ++j) { const u32x4 w = q.v16[j]; v[j][0] = hlo(w.x); v[j][1] = hhi(w.x); v[j][2] = hlo(w.y); v[j][3] = hhi(w.y); v[j][4] = hlo(w.z); v[j][5] = hhi(w.z); v[j][6] = hlo(w.w); v[j][7] = hhi(w.w); }
    }
    if (R.F) {
        float f[2][8];
#pragma unroll
        for (int j = 0; j < 2; ++j) UNPK_BF(f[j], q.f[j]);
        if (R.F2) {
            float e[2][8]; float ss = 0.f;
#pragma unroll
            for (int j = 0; j < 2; ++j) { UNPK_BF(e[j], q.e[j]);
#pragma unroll
                for (int c = 0; c < 8; ++c) ss += e[j][c] * e[j][c]; }
            const float r = 1.0f / sqrtf(wave_sum(ss) * (1.0f / DM) + EPS);
#pragma unroll
            for (int j = 0; j < 2; ++j)
#pragma unroll
                for (int c = 0; c < 8; ++c) v[j][c] += (1.0f / (1.0f + expf(-f[j][c]))) * (e[j][c] * r * gp[j][c]);
        } else {
            float ss = 0.f;
#pragma unroll
            for (int j = 0; j < 2; ++j)
#pragma unroll
                for (int c = 0; c < 8; ++c) ss += f[j][c] * f[j][c];
            const float r = 1.0f / sqrtf(wave_sum(ss) * (1.0f / DM) + EPS);
#pragma unroll
            for (int j = 0; j < 2; ++j)
#pragma unroll
                for (int c = 0; c < 8; ++c) v[j][c] += R.scale * ((f[j][c] * r) * gp[j][c]);
        }
        if (R.hout32) {
#pragma unroll
            for (int j = 0; j < 2; ++j) { __builtin_nontemporal_store((f32x4){v[j][0], v[j][1], v[j][2], v[j][3]}, (f32x4*)(R.hout32 + off + 512 * j)); __builtin_nontemporal_store((f32x4){v[j][4], v[j][5], v[j][6], v[j][7]}, (f32x4*)(R.hout32 + off + 512 * j + 4)); }
        } else {
#pragma unroll
            for (int j = 0; j < 2; ++j) {
                u32x4 w; w.x = pkh(v[j][0], v[j][1]); w.y = pkh(v[j][2], v[j][3]); w.z = pkh(v[j][4], v[j][5]); w.w = pkh(v[j][6], v[j][7]);
                __builtin_nontemporal_store(w, (u32x4*)(R.hout16 + off + 512 * j));
                v[j][0] = hlo(w.x); v[j][1] = hhi(w.x); v[j][2] = hlo(w.y); v[j][3] = hhi(w.y); v[j][4] = hlo(w.z); v[j][5] = hhi(w.z); v[j][6] = hlo(w.w); v[j][7] = hhi(w.w);
            }
        }
    }
    if (R.gnext) {
        float ss = 0.f;
#pragma unroll
        for (int j = 0; j < 2; ++j)
#pragma unroll
            for (int c = 0; c < 8; ++c) ss += v[j][c] * v[j][c];
        const float r2 = 1.0f / sqrtf(wave_sum(ss) * (1.0f / DM) + EPS);
        float un[2][8];
#pragma unroll
        for (int j = 0; j < 2; ++j) {
#pragma unroll
            for (int c = 0; c < 8; ++c) un[j][c] = (v[j][c] * r2) * gn[j][c];
            u32x4 w; w.x = pk2(un[j][0], un[j][1]); w.y = pk2(un[j][2], un[j][3]); w.z = pk2(un[j][4], un[j][5]); w.w = pk2(un[j][6], un[j][7]);
            *(u32x4*)(R.U + off + 512 * j) = w;
        }
        if (R.AF) {
            f32x4 acc = {0.f, 0.f, 0.f, 0.f};
#pragma unroll
            for (int j = 0; j < 2; ++j)
#pragma unroll
                for (int c = 0; c < 8; ++c) acc = acc + un[j][c] * *(const f32x4*)(R.AF + (size_t)(8 * lane + 512 * j + c) * 4);
            acc[0] = wave_sum(acc[0]); acc[1] = wave_sum(acc[1]); acc[2] = wave_sum(acc[2]); acc[3] = wave_sum(acc[3]);
            if (lane == 0) { f32x4 o; o[0] = log_sigmoid_f(acc[0] + bf[0]); o[1] = log_sigmoid_f(acc[1] + bf[1]); o[2] = log_sigmoid_f(acc[2] + bf[2]); o[3] = log_sigmoid_f(acc[3] + bf[3]); *(f32x4*)(R.LOGF + (size_t)m * 4) = o; }
        }
    }
    if (R.p) { u32x2 w; w.x = pk2(q.p[0], q.p[1]); w.y = pk2(q.p[2], q.p[3]); *(u32x2*)(R.Pbf + (size_t)m * PLE + 4 * lane) = w; }
}
__device__ __forceinline__ void row_pass(const RowArgs& R, int gw, int NGW, int lane) {
    float gp[2][8], gn[2][8];
#pragma unroll
    for (int j = 0; j < 2; ++j)
#pragma unroll
        for (int h = 0; h < 2; ++h) {
            const f32x4 a = R.gpost ? *(const f32x4*)(R.gpost + 8 * lane + 512 * j + 4 * h) : (f32x4){0.f, 0.f, 0.f, 0.f};
            const f32x4 b = R.gnext ? *(const f32x4*)(R.gnext + 8 * lane + 512 * j + 4 * h) : (f32x4){0.f, 0.f, 0.f, 0.f};
#pragma unroll
            for (int e = 0; e < 4; ++e) { gp[j][4 * h + e] = a[e]; gn[j][4 * h + e] = b[e]; }
        }
    const f32x4 bf = R.AF ? *(const f32x4*)R.bforget : (f32x4){0.f, 0.f, 0.f, 0.f};
    RowRaw qa, qb;
    if (gw < M) row_load(R, gw, lane, qa);
    for (int m = gw; m < M; m += 2 * NGW) {
        const int m1 = m + NGW, m2 = m + 2 * NGW;
        if (m1 < M) row_load(R, m1, lane, qb);
        row_process(R, m, lane, qa, gp, gn, bf);
        if (m2 < M) row_load(R, m2, lane, qa);
        if (m1 < M) row_process(R, m1, lane, qb, gp, gn, bf);
    }
}
__device__ __forceinline__ void cumsum_seq(const float* LOGF, float* CUM, int seq, int lane) {
    const int b = seq >> 2, h = seq & 3; const size_t base = ((size_t)b * SEQ + 32 * lane) * 4 + h;
    float s = 0.f;
#pragma unroll
    for (int i = 0; i < 32; ++i) s += LOGF[base + 4 * i];
    float incl = s;
#pragma unroll
    for (int o = 1; o < 64; o <<= 1) { const float n = __shfl_up(incl, o); if (lane >= o) incl += n; }
    float run = incl - s;
#pragma unroll
    for (int i = 0; i < 32; ++i) { run += LOGF[base + 4 * i]; CUM[base + 4 * i] = run * LOG2E; }
}

__device__ __forceinline__ int crow(int r, int hi) { return (r & 3) + 8 * (r >> 2) + 4 * hi; }
__device__ __forceinline__ int kvperm(int kv) { return (kv & 0x33) | (((kv >> 2) & 1) << 3) | (((kv >> 3) & 1) << 2); }
constexpr int KROW = 144;
template <int TYPE>
__device__ __forceinline__ void attn_tile(f32x16 (&o)[2], float& m, float& l, const bf16x8 (&qr)[4], const LAS unsigned char* Kt, const LAS unsigned char* VTt, int vt_stride,
                                          int kv0, int qpos, float cq, const LAS float* ckv, const LAS float* biasT, bool domask, int r32, int hi) {
    f32x16 p0, p1;
#pragma unroll
    for (int r = 0; r < 16; ++r) { p0[r] = 0.f; p1[r] = 0.f; }
    const LAS unsigned char* kp = Kt + r32 * KROW + 16 * hi;
#pragma unroll
    for (int d0 = 0; d0 < 4; ++d0) {
        const bf16x8 a0 = *(const LAS bf16x8*)(kp + 32 * d0), a1 = *(const LAS bf16x8*)(kp + 32 * KROW + 32 * d0);
        p0 = __builtin_amdgcn_mfma_f32_32x32x16_bf16(a0, qr[d0], p0, 0, 0, 0);
        p1 = __builtin_amdgcn_mfma_f32_32x32x16_bf16(a1, qr[d0], p1, 0, 0, 0);
    }
    if (TYPE == 0) {
#pragma unroll
        for (int g = 0; g < 4; ++g) {
            const f32x4 c0 = *(const LAS f32x4*)(ckv + 8 * g + 4 * hi), c1 = *(const LAS f32x4*)(ckv + 32 + 8 * g + 4 * hi);
#pragma unroll
            for (int e = 0; e < 4; ++e) { p0[4 * g + e] += cq - c0[e]; p1[4 * g + e] += cq - c1[e]; }
        }
        if (domask) {
#pragma unroll
            for (int r = 0; r < 16; ++r) { const int kv = kv0 + crow(r, hi); if (kv > qpos) p0[r] = NEGBIG; if (kv + 32 > qpos) p1[r] = NEGBIG; }
        }
    } else {
#pragma unroll
        for (int r = 0; r < 16; ++r) {
            const int d0 = qpos - (kv0 + crow(r, hi)), d1 = d0 - 32;
            const float b0 = biasT[d0 & 127], b1 = biasT[d1 & 127];
            p0[r] = ((unsigned)d0 < 128u) ? p0[r] + b0 : NEGBIG; p1[r] = ((unsigned)d1 < 128u) ? p1[r] + b1 : NEGBIG;
        }
    }
    float mx = fmaxf(p0[0], p1[0]);
#pragma unroll
    for (int r = 1; r < 16; ++r) mx = fmaxf(mx, fmaxf(p0[r], p1[r]));
    { const auto rr = __builtin_amdgcn_permlane32_swap(__float_as_uint(mx), __float_as_uint(mx), false, false); mx = fmaxf(__uint_as_float(rr[0]), __uint_as_float(rr[1])); }
    const float m_old = m, mn = fmaxf(m, mx), alpha = __builtin_amdgcn_exp2f(m - mn); m = mn;
    float s = 0.f;
#pragma unroll
    for (int r = 0; r < 16; ++r) { p0[r] = __builtin_amdgcn_exp2f(p0[r] - mn); p1[r] = __builtin_amdgcn_exp2f(p1[r] - mn); s += p0[r] + p1[r]; }
    l = l * alpha + s;
    if (__any(mn > m_old)) {
#pragma unroll
        for (int r = 0; r < 16; ++r) { o[0][r] *= alpha; o[1][r] *= alpha; }
    }
    bf16x8 pf[4];
    { u32x4 w;
      w.x = cvt_pk_bf16(p0[0], p0[1]); w.y = cvt_pk_bf16(p0[2], p0[3]); w.z = cvt_pk_bf16(p0[4], p0[5]); w.w = cvt_pk_bf16(p0[6], p0[7]); pf[0] = __builtin_bit_cast(bf16x8, w);
      w.x = cvt_pk_bf16(p0[8], p0[9]); w.y = cvt_pk_bf16(p0[10], p0[11]); w.z = cvt_pk_bf16(p0[12], p0[13]); w.w = cvt_pk_bf16(p0[14], p0[15]); pf[1] = __builtin_bit_cast(bf16x8, w);
      w.x = cvt_pk_bf16(p1[0], p1[1]); w.y = cvt_pk_bf16(p1[2], p1[3]); w.z = cvt_pk_bf16(p1[4], p1[5]); w.w = cvt_pk_bf16(p1[6], p1[7]); pf[2] = __builtin_bit_cast(bf16x8, w);
      w.x = cvt_pk_bf16(p1[8], p1[9]); w.y = cvt_pk_bf16(p1[10], p1[11]); w.z = cvt_pk_bf16(p1[12], p1[13]); w.w = cvt_pk_bf16(p1[14], p1[15]); pf[3] = __builtin_bit_cast(bf16x8, w); }
#pragma unroll
    for (int db = 0; db < 2; ++db) {
        const LAS unsigned char* vp = VTt + (32 * db + r32) * vt_stride + 16 * hi;
#pragma unroll
        for (int j = 0; j < 4; ++j) { const bf16x8 a = *(const LAS bf16x8*)(vp + 32 * j); o[db] = __builtin_amdgcn_mfma_f32_32x32x16_bf16(a, pf[j], o[db], 0, 0, 0); }
    }
}
__device__ __forceinline__ void attn_store(const f32x16 (&o)[2], float l, bf16_t* dst  , int hi) {
    float lt; { const auto rr = __builtin_amdgcn_permlane32_swap(__float_as_uint(l), __float_as_uint(l), false, false); lt = __uint_as_float(rr[0]) + __uint_as_float(rr[1]); }
    const float inv = 1.0f / lt;
#pragma unroll
    for (int db = 0; db < 2; ++db)
#pragma unroll
        for (int g = 0; g < 4; ++g) { u32x2 w; w.x = cvt_pk_bf16(o[db][4 * g] * inv, o[db][4 * g + 1] * inv); w.y = cvt_pk_bf16(o[db][4 * g + 2] * inv, o[db][4 * g + 3] * inv);
            *(u32x2*)(dst + 32 * db + 8 * g + 4 * hi) = w; }
}

constexpr int AVS = 272, A_K = 0, A_VT = 128 * KROW, A_C = A_VT + 64 * AVS, ABUF = A_C + 512;
__device__ __forceinline__ void attnA_unit(LAS unsigned char* lds, const bf16_t* PROJ, const float* CUM, bf16_t* YCAT, int bg, int bl, int h, int qb, int tid, int wave, int lane) {
    const int r32 = lane & 31, hi = lane >> 5, NS = 2 * (qb + 1), q0w = 256 * qb + 32 * wave, qpos = q0w + r32;
    const size_t prow = (size_t)bl * SEQ, grow = (size_t)bg * SEQ;
    bf16x8 qr[4];
    { const bf16_t* qp = PROJ + (prow + qpos) * NPROJ + 64 * h + 8 * hi;
#pragma unroll
      for (int d0 = 0; d0 < 4; ++d0) qr[d0] = *(const bf16x8*)(qp + 16 * d0); }
    const float cq = CUM[(grow + qpos) * 4 + h];
    const int lrow = tid >> 3, lch = tid & 7;
    const bf16_t* kg = PROJ + (prow + lrow) * NPROJ + 256 + 64 * h + 8 * lch;
    const bf16_t* vg = PROJ + (prow + 2 * lane) * NPROJ + 512 + 64 * h + 8 * wave;
    const float* cgp = CUM + (grow + (tid & 127)) * 4 + h;
    const int kst = A_K + lrow * KROW + lch * 16;
    const int vpos = 64 * ((2 * lane) >> 6) + kvperm((2 * lane) & 63), vst = A_VT + (8 * wave) * AVS + vpos * 2;
    u32x4 k0, k1, va, vb; float creg = 0.f;
#define A_LOAD(st) do { const size_t ro = (size_t)(st) * 128 * NPROJ; k0 = *(const u32x4*)(kg + ro); k1 = *(const u32x4*)(kg + ro + (size_t)64 * NPROJ); \
        va = *(const u32x4*)(vg + ro); vb = *(const u32x4*)(vg + ro + NPROJ); if (tid < 128) creg = cgp[(size_t)(st) * 128 * 4]; } while (0)
#define A_STORE(buf) do { LAS unsigned char* bb = lds + (buf) * ABUF; *(LAS u32x4*)(bb + kst) = k0; *(LAS u32x4*)(bb + kst + 64 * KROW) = k1; \
        LAS unsigned* vv = (LAS unsigned*)(bb + vst); \
        vv[0 * (AVS / 4)] = (va.x & 0xffffu) | (vb.x << 16); vv[1 * (AVS / 4)] = (va.x >> 16) | (vb.x & 0xffff0000u); \
        vv[2 * (AVS / 4)] = (va.y & 0xffffu) | (vb.y << 16); vv[3 * (AVS / 4)] = (va.y >> 16) | (vb.y & 0xffff0000u); \
        vv[4 * (AVS / 4)] = (va.z & 0xffffu) | (vb.z << 16); vv[5 * (AVS / 4)] = (va.z >> 16) | (vb.z & 0xffff0000u); \
        vv[6 * (AVS / 4)] = (va.w & 0xffffu) | (vb.w << 16); vv[7 * (AVS / 4)] = (va.w >> 16) | (vb.w & 0xffff0000u); \
        if (tid < 128) *(LAS float*)(bb + A_C + 4 * tid) = creg; } while (0)
    f32x16 o[2];
#pragma unroll
    for (int r = 0; r < 16; ++r) { o[0][r] = 0.f; o[1][r] = 0.f; }
    float m = NEGBIG, l = 0.f;
    A_LOAD(0); A_STORE(0); __syncthreads();
    for (int st = 0; st < NS; ++st) {
        if (st + 1 < NS) A_LOAD(st + 1);
        const LAS unsigned char* bb = lds + (st & 1) * ABUF;
#pragma unroll
        for (int sub = 0; sub < 2; ++sub) {
            const int t = 2 * st + sub;
            if (64 * t <= q0w + 31)
                attn_tile<0>(o, m, l, qr, bb + A_K + sub * 64 * KROW, bb + A_VT + sub * 128, AVS, 64 * t, qpos, cq, (const LAS float*)(bb + A_C) + 64 * sub, (const LAS float*)0, 64 * t + 63 > q0w, r32, hi);
        }
        if (st + 1 < NS) A_STORE((st + 1) & 1);
        __syncthreads();
    }
#undef A_LOAD
#undef A_STORE
    attn_store(o, l, YCAT + (grow + qpos) * YW + 64 * h, hi);
}
constexpr int D_K = 0, D_VT = 4 * 64 * KROW, D_VSTRIDE = 528, D_BIAS = D_VT + 64 * D_VSTRIDE, D_END = D_BIAS + 4 * 128 * 4;
__device__ __forceinline__ void attnD_unit(LAS unsigned char* lds, const bf16_t* PROJ, bf16_t* YCAT, const float* relb, const float* sinks, const CAS unsigned char* bucket, int bg, int bl, int kvh, int n, int tid, int wave, int lane) {
    const int r32 = lane & 31, hi = lane >> 5;
    const size_t prow = (size_t)bl * SEQ, grow = (size_t)bg * SEQ;
#pragma unroll
    for (int it = 0; it < 4; ++it) {
        const int idx = tid + 512 * it, i = idx >> 3, ch = idx & 7, pos = 128 * (n - 1) + i;
        if (pos >= 0) *(LAS u32x4*)(lds + D_K + (i >> 6) * (64 * KROW) + (i & 63) * KROW + ch * 16) = *(const u32x4*)(PROJ + (prow + pos) * NPROJ + 2560 + 64 * kvh + 8 * ch);
    }
#pragma unroll
    for (int it = 0; it < 2; ++it) {
        const int i = 2 * (lane + 64 * it), pos = 128 * (n - 1) + i;
        if (pos >= 0) {
            const bf16_t* src = PROJ + (prow + pos) * NPROJ + 2688 + 64 * kvh + 8 * wave;
            const u32x4 va = *(const u32x4*)src, vb = *(const u32x4*)(src + NPROJ);
            LAS unsigned* vv = (LAS unsigned*)(lds + D_VT + (8 * wave) * D_VSTRIDE + ((i >> 6) * 64 + kvperm(i & 63)) * 2);
            vv[0 * (D_VSTRIDE / 4)] = (va.x & 0xffffu) | (vb.x << 16); vv[1 * (D_VSTRIDE / 4)] = (va.x >> 16) | (vb.x & 0xffff0000u);
            vv[2 * (D_VSTRIDE / 4)] = (va.y & 0xffffu) | (vb.y << 16); vv[3 * (D_VSTRIDE / 4)] = (va.y >> 16) | (vb.y & 0xffff0000u);
            vv[4 * (D_VSTRIDE / 4)] = (va.z & 0xffffu) | (vb.z << 16); vv[5 * (D_VSTRIDE / 4)] = (va.z >> 16) | (vb.z & 0xffff0000u);
            vv[6 * (D_VSTRIDE / 4)] = (va.w & 0xffffu) | (vb.w << 16); vv[7 * (D_VSTRIDE / 4)] = (va.w >> 16) | (vb.w & 0xffff0000u);
        }
    }
    { const int g = tid >> 7, dist = tid & 127; ((LAS float*)(lds + D_BIAS))[tid] = relb[(int)bucket[dist] * 8 + 4 * kvh + g] * LOG2E; }
    __syncthreads();
#pragma unroll 1
    for (int k = wave; k < 16; k += 8) {
        const int g = k >> 2, j = k & 3, hq = 4 * kvh + g, qpos = 128 * n + 32 * j + r32;
        bf16x8 qr[4];
        { const bf16_t* qp = PROJ + (prow + qpos) * NPROJ + 2048 + 64 * hq + 8 * hi;
#pragma unroll
          for (int d0 = 0; d0 < 4; ++d0) qr[d0] = *(const bf16x8*)(qp + 16 * d0); }
        f32x16 o[2];
#pragma unroll
        for (int r = 0; r < 16; ++r) { o[0][r] = 0.f; o[1][r] = 0.f; }
        float m = sinks[hq] * LOG2E, l = (hi == 0) ? 1.0f : 0.0f;
        int jlo = (j >= 2) ? 1 : 0; const int jhi = (j >= 2) ? 3 : 2; if (n == 0 && jlo < 2) jlo = 2;
        for (int jt = jlo; jt <= jhi; ++jt)
            attn_tile<1>(o, m, l, qr, lds + D_K + jt * (64 * KROW), lds + D_VT + jt * 128, D_VSTRIDE, 128 * (n - 1) + 64 * jt, qpos, 0.f, (const LAS float*)0, (const LAS float*)(lds + D_BIAS) + 128 * g, true, r32, hi);
        attn_store(o, l, YCAT + (grow + qpos) * YW + 768 + 64 * hq, hi);
    }
    __syncthreads();
}
constexpr int CW_OFF = 94 * 256 * 4;
__device__ __forceinline__ void conv_weights_to_lds(LAS unsigned char* lds, const float* wdw, int tid) {
    LAS float* w = (LAS float*)(lds + CW_OFF);
#pragma unroll
    for (int it = 0; it < 4; ++it) { const int idx = tid + 512 * it; if (idx < 31 * 64) *(LAS f32x4*)(w + 4 * idx) = *(const f32x4*)(wdw + 4 * idx); }
}
__device__ __forceinline__ void conv_unit(LAS unsigned char* lds, const bf16_t* PROJ, bf16_t* YCAT, const float* wshort, const float* dwb, const float* lng, const float* lnb, int bg, int bl, int tb, int tid, int wave, int lane) {
    const size_t prow = (size_t)bl * SEQ, grow = (size_t)bg * SEQ; const int t0 = 64 * tb;
    {
        const int grp = tid & 31;
        f32x4 w0[3], w1[3];
#pragma unroll
        for (int k = 0; k < 3; ++k) { w0[k] = *(const f32x4*)(wshort + k * 256 + 8 * grp); w1[k] = *(const f32x4*)(wshort + k * 256 + 8 * grp + 4); }
#pragma unroll 2
        for (int it = 0; it < 4; ++it) {
            const int tok = (tid >> 5) + 16 * it, t = t0 + tok;
            const bf16_t* src = PROJ + (prow + t) * NPROJ + 768 + 8 * grp;
            u32x4 c[3], x[3];
#pragma unroll
            for (int k = 0; k < 3; ++k) {
                const int tt = t - 2 + k;
                if (tt >= 0) { c[k] = *(const u32x4*)(src + (k - 2) * NPROJ + 256); x[k] = *(const u32x4*)(src + (k - 2) * NPROJ + 512); }
                else { c[k] = (u32x4){0u, 0u, 0u, 0u}; x[k] = (u32x4){0u, 0u, 0u, 0u}; }
            }
            const u32x4 b = *(const u32x4*)src;
            float acc[8];
#pragma unroll
            for (int e = 0; e < 8; ++e) acc[e] = 0.f;
#pragma unroll
            for (int k = 0; k < 3; ++k) {
                acc[0] += w0[k][0] * (bflo(c[k].x) * bflo(x[k].x)); acc[1] += w0[k][1] * (bfhi(c[k].x) * bfhi(x[k].x)); acc[2] += w0[k][2] * (bflo(c[k].y) * bflo(x[k].y)); acc[3] += w0[k][3] * (bfhi(c[k].y) * bfhi(x[k].y));
                acc[4] += w1[k][0] * (bflo(c[k].z) * bflo(x[k].z)); acc[5] += w1[k][1] * (bfhi(c[k].z) * bfhi(x[k].z)); acc[6] += w1[k][2] * (bflo(c[k].w) * bflo(x[k].w)); acc[7] += w1[k][3] * (bfhi(c[k].w) * bfhi(x[k].w));
            }
            u32x4 w; w.x = cvt_pk_bf16(bflo(b.x) * acc[0], bfhi(b.x) * acc[1]); w.y = cvt_pk_bf16(bflo(b.y) * acc[2], bfhi(b.y) * acc[3]); w.z = cvt_pk_bf16(bflo(b.z) * acc[4], bfhi(b.z) * acc[5]); w.w = cvt_pk_bf16(bflo(b.w) * acc[6], bfhi(b.w) * acc[7]);
            *(u32x4*)(YCAT + (grow + t) * YW + 256 + 8 * grp) = w;
        }
    }
    LAS float* glu = (LAS float*)lds;
#pragma unroll 3
    for (int it = 0; it < 6; ++it) {
        const int idx = tid + 512 * it;
        if (idx < 94 * 32) {
            const int r = idx >> 5, grp = idx & 31, tt = t0 - 30 + r;
            f32x4 g0 = {0.f, 0.f, 0.f, 0.f}, g1 = {0.f, 0.f, 0.f, 0.f};
            if (tt >= 0) {
                const bf16_t* src = PROJ + (prow + tt) * NPROJ + 1536 + 8 * grp;
                const u32x4 a = *(const u32x4*)src, s = *(const u32x4*)(src + 256);
                g0[0] = bflo(a.x) * sigmoid_f(bflo(s.x)); g0[1] = bfhi(a.x) * sigmoid_f(bfhi(s.x)); g0[2] = bflo(a.y) * sigmoid_f(bflo(s.y)); g0[3] = bfhi(a.y) * sigmoid_f(bfhi(s.y));
                g1[0] = bflo(a.z) * sigmoid_f(bflo(s.z)); g1[1] = bfhi(a.z) * sigmoid_f(bfhi(s.z)); g1[2] = bflo(a.w) * sigmoid_f(bflo(s.w)); g1[3] = bfhi(a.w) * sigmoid_f(bfhi(s.w));
            }
            *(LAS f32x4*)(glu + r * 256 + 8 * grp) = g0; *(LAS f32x4*)(glu + r * 256 + 8 * grp + 4) = g1;
        }
    }
    __syncthreads();
    {
        f32x4 acc[8];
#pragma unroll
        for (int i = 0; i < 8; ++i) acc[i] = (f32x4){0.f, 0.f, 0.f, 0.f};
        const LAS float* gb = glu + (8 * wave) * 256 + 4 * lane;
        const LAS float* wl = (const LAS float*)(lds + CW_OFF) + 4 * lane;
#pragma unroll 2
        for (int k = 0; k < 31; ++k) {
            const f32x4 wk = *(const LAS f32x4*)(wl + k * 256);
#pragma unroll
            for (int i = 0; i < 8; ++i) acc[i] = acc[i] + wk * *(const LAS f32x4*)(gb + (i + k) * 256);
        }
        const f32x4 bias = *(const f32x4*)(dwb + 4 * lane), gain = *(const f32x4*)(lng + 4 * lane), lb = *(const f32x4*)(lnb + 4 * lane);
#pragma unroll
        for (int i = 0; i < 8; ++i) {
            const f32x4 v = acc[i] + bias;
            const float mean = wave_sum((v[0] + v[1]) + (v[2] + v[3])) * (1.0f / 256.0f);
            const f32x4 d = v - mean;
            const float var = wave_sum((d[0] * d[0] + d[1] * d[1]) + (d[2] * d[2] + d[3] * d[3])) * (1.0f / 256.0f);
            const float rs = 1.0f / sqrtf(var + EPS);
            f32x4 y = (d * rs) * gain + lb;
#pragma unroll
            for (int e = 0; e < 4; ++e) y[e] = y[e] * sigmoid_f(y[e]);
            u32x2 w; w.x = cvt_pk_bf16(y[0], y[1]); w.y = cvt_pk_bf16(y[2], y[3]);
            *(u32x2*)(YCAT + (grow + t0 + 8 * wave + i) * YW + 512 + 4 * lane) = w;
        }
    }
    __syncthreads();
}
__device__ __forceinline__ void mixer_phase(const CAS Args* a, int L, int half, LAS unsigned char* lds, int bid, int tid, int wave, int lane) {
    const bf16_t* PROJ = (const bf16_t*)(a->ws + WS_PROJ); bf16_t* YCAT = (bf16_t*)(a->ws + WS_YCAT); const float* CUM = (const float*)(a->ws + WS_CUM);
    const int G = gridDim.x, B0 = 16 * half;
    for (int u = bid; u < 256; u += G) {
        const int bl = u >> 4, h = (u >> 2) & 3, pr = u & 3;
        attnA_unit(lds, PROJ, CUM, YCAT, B0 + bl, bl, h, 7 - pr, tid, wave, lane);
        attnA_unit(lds, PROJ, CUM, YCAT, B0 + bl, bl, h, pr, tid, wave, lane);
    }
    for (int u = bid; u < 512; u += G) {
        const int bl = u >> 5, kvh = (u >> 4) & 1, n = u & 15;
        attnD_unit(lds, PROJ, YCAT, a->in[16], a->in[15] + L * 8, a->bucket, B0 + bl, bl, kvh, n, tid, wave, lane);
    }
    conv_weights_to_lds(lds, a->in[11] + (size_t)L * 31 * 256, tid);
    for (int u = bid; u < 512; u += G) {
        const int bl = u >> 5, tb = u & 31;
        conv_unit(lds, PROJ, YCAT, a->in[10] + (size_t)L * 3 * 256, a->in[12] + L * 256, a->in[13] + L * 256, a->in[14] + L * 256, B0 + bl, bl, tb, tid, wave, lane);
    }
}

#define XB_TMO      128
#define XB_XCNT(j)  (256  + 64 * (j))
#define XB_XSUB(j)  (1280 + 64 * (j))
#define XB_XGEN(j)  (2304 + 64 * (j))
#define XB_TOP      3328
#define XB_TOPGEN   3392
#define XCD_BAR_WORDS 3456
#define XB_SPIN_CAP (1u << 22)

__device__ __forceinline__ unsigned xb_ld(unsigned* p)              { return __hip_atomic_load(p, __ATOMIC_RELAXED, __HIP_MEMORY_SCOPE_AGENT); }
__device__ __forceinline__ unsigned xb_add(unsigned* p, unsigned v) { return __hip_atomic_fetch_add(p, v, __ATOMIC_RELAXED, __HIP_MEMORY_SCOPE_AGENT); }
__device__ __forceinline__ unsigned xb_xcc_id() { return (unsigned)__builtin_amdgcn_s_getreg((3 << 11) | 20) & 0xFu; }
#define XB_SPIN(cond, bar) do { unsigned _sp = 0; while (cond) { __builtin_amdgcn_s_sleep(1); \
    if ((++_sp & 255u) == 0u) { if (xb_ld(&(bar)[XB_TMO])) break; if (_sp > XB_SPIN_CAP) { atomicAdd(&(bar)[XB_TMO], 1u); break; } } } } while (0)

struct XcdBarrier {
    unsigned* bar; unsigned x;
    volatile LAS unsigned* st;
};

__device__ __forceinline__ XcdBarrier xcd_barrier_post(unsigned* bar, volatile LAS unsigned* st) {
    XcdBarrier b; b.bar = bar; b.x = xb_xcc_id(); b.st = st;
    if (threadIdx.x == 0) (void)xb_add(&bar[XB_XCNT(b.x)], 1u);
    return b;
}
__device__ __forceinline__ void xcd_barrier_complete(unsigned* bar, unsigned x, unsigned& nloc, unsigned& nx) {
    const unsigned G = gridDim.x * gridDim.y * gridDim.z;
    unsigned sum, cnt, mine, sp = 0u;
    for (;;) {
        sum = 0u; cnt = 0u; mine = 0u;
#pragma unroll
        for (unsigned j = 0; j < 16; ++j) { const unsigned c = xb_ld(&bar[XB_XCNT(j)]); sum += c; cnt += (c > 0u) ? 1u : 0u; mine = (j == x) ? c : mine; }
        if (sum == G) break;
        __builtin_amdgcn_s_sleep(1);
        if ((++sp & 255u) == 0u) { if (xb_ld(&bar[XB_TMO])) break; if (sp > XB_SPIN_CAP) { atomicAdd(&bar[XB_TMO], 1u); break; } }
    }
    nloc = mine > 0u ? mine : 1u; nx = cnt > 0u ? cnt : 1u;
}

__device__ __forceinline__ void xcd_barrier(const XcdBarrier& b) {
    asm volatile("s_waitcnt vmcnt(0)" ::: "memory");
    __syncthreads();
    if (threadIdx.x == 0) {
        unsigned* bar = b.bar;
        __builtin_amdgcn_s_waitcnt(0);
        unsigned nloc = b.st[0], nx = b.st[1];
        if (nloc == 0u) { xcd_barrier_complete(bar, b.x, nloc, nx); b.st[0] = nloc; b.st[1] = nx; }
        const unsigned old = xb_add(&bar[XB_XSUB(b.x)], 1u);
        const unsigned gen = old / nloc;
        if (old + 1u == (gen + 1u) * nloc) {
            __builtin_amdgcn_fence(__ATOMIC_RELEASE, "agent");
            asm volatile("s_waitcnt vmcnt(0)" ::: "memory");
            const unsigned og = xb_add(&bar[XB_TOP], 1u);
            const unsigned tg = og / nx;
            if (og + 1u == (tg + 1u) * nx) xb_add(&bar[XB_TOPGEN], 1u);
            else XB_SPIN(xb_ld(&bar[XB_TOPGEN]) == tg, bar);
            __builtin_amdgcn_fence(__ATOMIC_ACQUIRE, "agent");
            xb_add(&bar[XB_XGEN(b.x)], 1u);
            asm volatile("s_waitcnt vmcnt(0)" ::: "memory");
        } else {
            XB_SPIN(xb_ld(&bar[XB_XGEN(b.x)]) == gen, bar);
            __builtin_amdgcn_fence(__ATOMIC_ACQUIRE, "agent");
            asm volatile("s_waitcnt vmcnt(0)" ::: "memory");
        }
    }
    __syncthreads();
}

__global__ void __launch_bounds__(NTHREADS, 2) mega(Args a_) {
    extern __shared__ __attribute__((aligned(16))) unsigned char lds_raw[];
    LAS unsigned char* lds = (LAS unsigned char*)lds_raw;
    const int ph_lo = a_.ph_lo, ph_hi = a_.ph_hi;
    { volatile LAS unsigned* bst = (volatile LAS unsigned*)(lds + 131072 + 64);
      if (threadIdx.x == 0) { bst[0] = 0u; bst[1] = 0u; }
      __syncthreads();
      (void)xcd_barrier_post((unsigned*)(a_.ws + WS_CTL_BAR), bst); }
    for (int ph = ph_lo; ph < ph_hi; ++ph) {
        const CAS Args* a = (const CAS Args*)__builtin_amdgcn_kernarg_segment_ptr();
        asm volatile("" : "+s"(a));
#define PH_IDS int tid = threadIdx.x; asm volatile("" : "+v"(tid)); const int lane = tid & 63, wave = __builtin_amdgcn_readfirstlane(tid >> 6); int bid = blockIdx.x; asm volatile("" : "+s"(bid)); const int G = gridDim.x, gw = bid * NWAVES + wave, NGW = G * NWAVES; (void)lane; (void)gw; (void)NGW; (void)G;
        unsigned char* ws = a->ws; float* OUT = a->out; unsigned short* H16 = (unsigned short*)(ws + WS_U);
        const int L = ph / PH_PER_LAYER, s = ph % PH_PER_LAYER;
        if (s == 0 && L > 0) continue;
        unsigned char* wsw = ws + ((L & 1) ? WS_WB - WS_W : 0);
        bf16_t* U = (bf16_t*)a->out; bf16_t* HID = (bf16_t*)(ws + WS_HID); bf16_t* F = (bf16_t*)(ws + WS_F); bf16_t* F2 = (bf16_t*)(ws + WS_F2);
        bf16_t* PROJ = (bf16_t*)(ws + WS_PROJ); bf16_t* YCAT = (bf16_t*)(ws + WS_YCAT); bf16_t* MERGED = (bf16_t*)(ws + WS_MERGED);
        float* LOGF = (float*)(ws + WS_LOGF); float* CUM = (float*)(ws + WS_CUM); bf16_t* PBF = (bf16_t*)(ws + WS_PBF);
        if (s == 0) { PH_IDS
            wconv_phase(a, L, -1, lds, gw, NGW, wave, lane);
            if (L == 0) { RowArgs R{a->in[0], nullptr, nullptr, nullptr, nullptr, nullptr, nullptr, 0.f, a->in[2], U, nullptr, nullptr, nullptr, nullptr, nullptr}; row_pass(R, gw, NGW, lane); }
            __syncthreads();
        } else if (s == 1 || s == 12) { PH_IDS
            pg8::Gemm g{U, (const bf16_t*)(wsw + (s == 1 ? W_GU1 : W_GU2)), M, 2 * FF, DM}; pg8::StaticOrder S; S.init(M, 2 * FF, G, bid);
            pg8::EpiSwiglu E{HID, FF};
            pg8::gemm_phase<pg8::EpiSwiglu, pg8::StaticOrder, true, true>(lds, g, S, E);
        } else if (s == 2 || s == 10 || s == 13 || s == 15) { PH_IDS
            const int nrep = (s == 15) ? 2 : 1;
            for (int rep = 0; rep < nrep; ++rep) {
                pg8::Gemm g; bf16_t* out;
                if (s == 2) { g = pg8::Gemm{HID, (const bf16_t*)(wsw + W_D1), M, DM, FF}; out = F; }
                else if (s == 13) { g = pg8::Gemm{HID, (const bf16_t*)(wsw + W_D2), M, DM, FF}; out = F; }
                else if (s == 10) { g = pg8::Gemm{MERGED, (const bf16_t*)(wsw + W_O), M, DM, DM}; out = F; }
                else if (rep == 0) { g = pg8::Gemm{U, (const bf16_t*)(wsw + W_PG), M, DM, DM}; out = F; }
                else { g = pg8::Gemm{PBF, (const bf16_t*)(wsw + W_PLE), M, DM, PLE}; out = F2; }
                pg8::StaticOrder S; S.init(M, DM, G, bid);
                pg8::EpiBf16 E{out, DM};
                pg8::gemm_phase<pg8::EpiBf16, pg8::StaticOrder, true, true>(lds, g, S, E);
            }
        } else if (s == 4 || s == 7) { PH_IDS
            const int half = (s == 7) ? 1 : 0;
            if (half == 0 && wave == 0) { for (int q = bid; q < NB * 4; q += G) cumsum_seq(LOGF, CUM, q, lane); }
            pg8::Gemm g{U + (size_t)half * MH * DM, (const bf16_t*)(wsw + W_IN), MH, NPROJ, DM}; pg8::StaticOrder S; S.init(MH, NPROJ, G, bid);
            pg8::EpiProj E{PROJ, NPROJ, a->in[9] + (size_t)L * 4096, QSCALE};
            pg8::gemm_phase<pg8::EpiProj, pg8::StaticOrder, true, true>(lds, g, S, E);
        } else if (s == 5 || s == 8) { PH_IDS
            mixer_phase(a, L, (s == 8) ? 1 : 0, lds, bid, tid, wave, lane);
            if (L + 1 < DEPTH) wconv_phase(a, L + 1, (s == 8) ? 1 : 0, lds, gw, NGW, wave, lane);
        } else if (s == 6 || s == 9) { PH_IDS
            const int half = (s == 9) ? 1 : 0;
            pg8::Gemm g{YCAT + (size_t)half * MH * YW, (const bf16_t*)(wsw + W_BR), MH, DM, YW}; pg8::StaticOrder S; S.init(MH, DM, G, bid);
            pg8::EpiMerge E{MERGED + (size_t)half * MH * DM, DM, PROJ + 2816, NPROJ};
            pg8::gemm_phase<pg8::EpiMerge, pg8::StaticOrder, true, true>(lds, g, S, E);
        } else { PH_IDS
            RowArgs R;
            const bool last = (L + 1 == DEPTH);
            if (s == 3)       R = RowArgs{L == 0 ? a->in[0] : nullptr, H16, nullptr, H16, F, nullptr, a->in[5] + L * DM, 0.5f, a->in[6] + L * DM, U, (const float*)(wsw + W_AF), a->in[8] + L * 4, LOGF, nullptr, nullptr};
            else if (s == 11) R = RowArgs{nullptr, H16, nullptr, H16, F, nullptr, a->in[22] + L * DM, 1.0f, a->in[23] + L * DM, U, nullptr, nullptr, nullptr, nullptr, nullptr};
            else if (s == 14) R = RowArgs{nullptr, H16, nullptr, H16, F, nullptr, a->in[26] + L * DM, 0.5f, a->in[27] + L * DM, U, nullptr, nullptr, nullptr, a->in[1] + (size_t)L * M * PLE, PBF};
            else              R = RowArgs{nullptr, H16, last ? OUT : nullptr, H16, F, F2, a->in[30] + L * DM, 1.0f, last ? nullptr : a->in[2] + (L + 1) * DM, U, nullptr, nullptr, nullptr, nullptr, nullptr};
            row_pass(R, gw, NGW, lane);
        }
        if (ph + 1 < ph_hi) { if (ph == ph_lo) cg::this_grid().sync(); else { XcdBarrier xbar; xbar.bar = (unsigned*)(a->ws + WS_CTL_BAR); xbar.x = xb_xcc_id(); xbar.st = (volatile LAS unsigned*)(lds + 131072 + 64); xcd_barrier(xbar); } }
    }
}

extern "C" void kernel_launch(void* const* d_in, const int* in_sizes, int n_in, void* d_out, int out_size, void* d_ws, size_t ws_size, hipStream_t stream) {
    static int grid = 0;
    if (grid == 0) {
        if (n_in != 31 || out_size != M * DM || ws_size < WS_NEED) { fprintf(stderr, "kernel_launch: unexpected shapes (n_in %d, out %d, ws %zu)\n", n_in, out_size, ws_size); grid = -1; return; }
        int dev = 0, cus = 0, per_cu = 0;
        if (hipGetDevice(&dev) != hipSuccess || hipDeviceGetAttribute(&cus, hipDeviceAttributeMultiprocessorCount, dev) != hipSuccess) { grid = -1; return; }
        if (hipFuncSetAttribute((const void*)mega, hipFuncAttributeMaxDynamicSharedMemorySize, LDS_BYTES) != hipSuccess) { fprintf(stderr, "kernel_launch: hipFuncSetAttribute failed\n"); grid = -1; return; }
        if (hipOccupancyMaxActiveBlocksPerMultiprocessor(&per_cu, (const void*)mega, NTHREADS, LDS_BYTES) != hipSuccess || per_cu < 1) { fprintf(stderr, "kernel_launch: occupancy query says %d\n", per_cu); per_cu = 1; }
        (void)hipGetLastError();
        grid = cus * per_cu;
        fprintf(stderr, "kernel_launch: grid %d (cus %d x %d)\n", grid, cus, per_cu);
    }
    if (grid < 0) return;
    Args a{};
    for (int i = 0; i < 31; ++i) a.in[i] = (const float*)d_in[i];
    a.out = (float*)d_out; a.ws = (unsigned char*)d_ws;
    for (int d = 0; d < 128; ++d) {
        int bkt;
        if (d < 16) bkt = d;
        else { const float v = logf((float)d / 16.0f) / (float)log(128.0 / 16.0) * 16.0f; bkt = 16 + (int)v; if (bkt > 31) bkt = 31; }
        a.bucket[d] = (unsigned char)bkt;
    }
#if MK_ONE_LAUNCH
    if (hipMemsetAsync(d_ws, 0, CTL_ZERO_BYTES, stream) != hipSuccess) { fprintf(stderr, "kernel_launch: memset failed\n"); return; }
    a.ph_lo = 0; a.ph_hi = N_PHASES;
    void* args[] = {&a};
    hipError_t e = hipLaunchCooperativeKernel((const void*)mega, dim3(grid), dim3(NTHREADS), args, LDS_BYTES, stream);
    if (e != hipSuccess) fprintf(stderr, "kernel_launch: cooperative launch failed: %s (grid %d)\n", hipGetErrorString(e), grid);
#else
    for (int ph = 0; ph < N_PHASES; ++ph) {
        a.ph_lo = ph; a.ph_hi = ph + 1;
        hipLaunchKernelGGL(mega, dim3(grid), dim3(NTHREADS), LDS_BYTES, stream, a);
    }
#endif
}
```

```cpp
#include <hip/hip_runtime.h>
#include <hip/hip_cooperative_groups.h>
#include <cstdio>
#include <cstdint>
#include <cmath>
namespace cg = cooperative_groups;

#ifndef MK_ONE_LAUNCH
#define MK_ONE_LAUNCH 1
#endif
namespace pg8 {
#define PG8_LAS __attribute__((address_space(3)))
typedef unsigned short bf16_t;
typedef short bf16x8 __attribute__((ext_vector_type(8)));
typedef float f32x4 __attribute__((ext_vector_type(4)));
typedef unsigned u32x4 __attribute__((ext_vector_type(4)));
typedef unsigned u32x2 __attribute__((ext_vector_type(2)));
constexpr int BM = 256, BK = 64, HALF = 128, HTB = HALF * BK * 2  , STAGE_BYTES = 8 * HTB, NXCD = 8, WGM = 8;

__host__ __device__ __forceinline__ int lds_byte(int r, int c) { const int st = (r >> 4) * 2 + (c >> 5), rr = r & 15, cc = c & 31, ob = rr * 64 + cc * 2; return st * 1024 + (ob ^ (((ob >> 9) & 1) << 5)); }
__host__ __device__ __forceinline__ void stage_rc(int b, int& R, int& C) { const int st = b / 1024, sb = b % 1024, swz = sb ^ (((sb >> 9) & 1) << 5); R = (st >> 1) * 16 + swz / 64; C = (st & 1) * 32 + (swz % 64) / 2; }
__host__ __device__ __forceinline__ int perm32(int rho) { const int n = rho >> 4, i = rho & 15; return 8 * (i >> 2) + 4 * n + (i & 3); }

struct Unit { int pm, pn; };
struct Gemm { const bf16_t* A; const bf16_t* Bt; int M, N, K; };

struct StaticOrder {
    int nM, nN, nwg, G, c;
    __host__ __device__ void init(int M, int N, int G_, int c_) { nM = M / BM; nN = N / BM; nwg = nM * nN; G = G_; c = c_; }
    __host__ __device__ bool next(int i, Unit& u) const {
        const long L = (long)i * G + c; if (L >= nwg) return false;
        int wgid = (int)L; { const int q = nwg / NXCD, r = nwg % NXCD, xcd = wgid % NXCD, off = wgid / NXCD; wgid = (xcd < r ? xcd * (q + 1) : r * (q + 1) + (xcd - r) * q) + off; }
        const int nig = WGM * nN, gid = wgid / nig, fm = gid * WGM, gsz = (nM - fm) < WGM ? (nM - fm) : WGM;
        u.pm = fm + ((wgid % nig) % gsz); u.pn = (wgid % nig) / gsz; return true;
    }
    __device__ __forceinline__ void a_ready(const Unit&) const {}
    __device__ __forceinline__ void done(const Unit&) const {}
};

__device__ __forceinline__ unsigned cvt_pk_bf16(float lo, float hi) { unsigned r; asm volatile("v_cvt_pk_bf16_f32 %0, %1, %2" : "=v"(r) : "v"(lo), "v"(hi)); return r; }
typedef float f32x2 __attribute__((ext_vector_type(2)));

__device__ __forceinline__ float bf2f(unsigned short v) { return __uint_as_float(((unsigned)v) << 16); }
__device__ __forceinline__ float bflo(unsigned w) { return __uint_as_float(w << 16); }
__device__ __forceinline__ float bfhi(unsigned w) { return __uint_as_float(w & 0xffff0000u); }
__device__ __forceinline__ float sigmoid_f(float x) { return __builtin_amdgcn_rcpf(1.0f + __builtin_amdgcn_exp2f(-1.4426950408889634f * x)); }

struct EpiSwiglu {
    static constexpr bool PERM = true, AFTER_DRAIN = false, HOOK = false;
    bf16_t* O; int ldc;
    __device__ __forceinline__ void operator()(const f32x4 (&acc)[2][2][4][2], const Unit& u, int wr, int wc, int fr, int fq) const {
        const int row0 = u.pm * BM + wr * 64 + fr, col0 = u.pn * HALF + wc * 32 + 8 * fq;
#pragma unroll
        for (int ai = 0; ai < 2; ++ai)
#pragma unroll
            for (int m = 0; m < 4; ++m) {
                bf16_t* rowp = O + (size_t)(row0 + ai * HALF + m * 16) * ldc + col0;
                float v[8];
#pragma unroll
                for (int n = 0; n < 2; ++n)
#pragma unroll
                    for (int e = 0; e < 4; ++e) { const float g = acc[ai][0][m][n][e], up = acc[ai][1][m][n][e]; v[4 * n + e] = g * sigmoid_f(g) * up; }
                u32x4 w; w.x = cvt_pk_bf16(v[0], v[1]); w.y = cvt_pk_bf16(v[2], v[3]); w.z = cvt_pk_bf16(v[4], v[5]); w.w = cvt_pk_bf16(v[6], v[7]);
                *(u32x4*)rowp = w;
            }
    }
};
struct EpiF32 {
    static constexpr bool PERM = false, AFTER_DRAIN = false, HOOK = false;
    float* O; int ldc;
    __device__ __forceinline__ void operator()(const f32x4 (&acc)[2][2][4][2], const Unit& u, int wr, int wc, int fr, int fq) const {
        const int row0 = u.pm * BM + wr * 64 + fr, col0 = u.pn * BM + wc * 32 + 4 * fq;
#pragma unroll
        for (int ai = 0; ai < 2; ++ai)
#pragma unroll
            for (int m = 0; m < 4; ++m) {
                float* rowp = O + (size_t)(row0 + ai * HALF + m * 16) * ldc + col0;
#pragma unroll
                for (int bj = 0; bj < 2; ++bj)
#pragma unroll
                    for (int n = 0; n < 2; ++n) *(f32x4*)(rowp + bj * HALF + n * 16) = acc[ai][bj][m][n];
            }
    }
};
struct EpiBf16 {
    static constexpr bool PERM = true, AFTER_DRAIN = false, HOOK = false;
    bf16_t* O; int ldc;
    __device__ __forceinline__ void operator()(const f32x4 (&acc)[2][2][4][2], const Unit& u, int wr, int wc, int fr, int fq) const {
        const int row0 = u.pm * BM + wr * 64 + fr, col0 = u.pn * BM + wc * 32 + 8 * fq;
#pragma unroll
        for (int ai = 0; ai < 2; ++ai)
#pragma unroll
            for (int m = 0; m < 4; ++m) {
                bf16_t* rowp = O + (size_t)(row0 + ai * HALF + m * 16) * ldc + col0;
#pragma unroll
                for (int bj = 0; bj < 2; ++bj) {
                    const f32x4 v0 = acc[ai][bj][m][0], v1 = acc[ai][bj][m][1];
                    u32x4 w; w.x = cvt_pk_bf16(v0[0], v0[1]); w.y = cvt_pk_bf16(v0[2], v0[3]); w.z = cvt_pk_bf16(v1[0], v1[1]); w.w = cvt_pk_bf16(v1[2], v1[3]);
                    *(u32x4*)(rowp + bj * HALF) = w;
                }
            }
    }
};
struct EpiProj {
    static constexpr bool PERM = true, AFTER_DRAIN = false, HOOK = false;
    bf16_t* O; int ldc; const float* bgate; float qscale;
    __device__ __forceinline__ void operator()(const f32x4 (&acc)[2][2][4][2], const Unit& u, int wr, int wc, int fr, int fq) const {
        const int row0 = u.pm * BM + wr * 64 + fr;
        if (u.pn >= 11) {
            const int oc = 64 * (u.pn - 11) + 16 * wc + 4 * fq;
            f32x4 bv[4];
#pragma unroll
            for (int k = 0; k < 4; ++k) bv[k] = *(const f32x4*)(bgate + 1024 * k + oc);
#pragma unroll
            for (int ai = 0; ai < 2; ++ai)
#pragma unroll
                for (int m = 0; m < 4; ++m) {
                    bf16_t* rowp = O + (size_t)(row0 + ai * HALF + m * 16) * ldc + 2816 + oc;
                    f32x4 g0 = acc[ai][0][m][0] + bv[0], g1 = acc[ai][0][m][1] + bv[1], g2 = acc[ai][1][m][0] + bv[2], g3 = acc[ai][1][m][1] + bv[3], r1, r2, r3;
#pragma unroll
                    for (int e = 0; e < 4; ++e) {
                        g0[e] = fmaxf(sigmoid_f(g0[e]), 1e-6f); g1[e] = fmaxf(sigmoid_f(g1[e]), 1e-6f); g2[e] = fmaxf(sigmoid_f(g2[e]), 1e-6f); g3[e] = fmaxf(sigmoid_f(g3[e]), 1e-6f);
                        r1[e] = g0[e] * __builtin_amdgcn_rcpf(g1[e]); r2[e] = g1[e] * __builtin_amdgcn_rcpf(g2[e]); r3[e] = g2[e] * __builtin_amdgcn_rcpf(g3[e]);
                    }
                    u32x2 w;
                    w.x = cvt_pk_bf16(r1[0], r1[1]); w.y = cvt_pk_bf16(r1[2], r1[3]); *(u32x2*)(rowp) = w;
                    w.x = cvt_pk_bf16(r2[0], r2[1]); w.y = cvt_pk_bf16(r2[2], r2[3]); *(u32x2*)(rowp + 1024) = w;
                    w.x = cvt_pk_bf16(r3[0], r3[1]); w.y = cvt_pk_bf16(r3[2], r3[3]); *(u32x2*)(rowp + 2048) = w;
                    w.x = cvt_pk_bf16(g3[0], g3[1]); w.y = cvt_pk_bf16(g3[2], g3[3]); *(u32x2*)(rowp + 3072) = w;
                }
        } else {
            const int col0 = u.pn * BM + wc * 32 + 8 * fq;
            const float sc = (u.pn == 0 || u.pn == 8 || u.pn == 9) ? qscale : 1.0f;
#pragma unroll
            for (int ai = 0; ai < 2; ++ai)
#pragma unroll
                for (int m = 0; m < 4; ++m) {
                    bf16_t* rowp = O + (size_t)(row0 + ai * HALF + m * 16) * ldc + col0;
#pragma unroll
                    for (int bj = 0; bj < 2; ++bj) {
                        const f32x4 v0 = acc[ai][bj][m][0] * sc, v1 = acc[ai][bj][m][1] * sc;
                        u32x4 w; w.x = cvt_pk_bf16(v0[0], v0[1]); w.y = cvt_pk_bf16(v0[2], v0[3]); w.z = cvt_pk_bf16(v1[0], v1[1]); w.w = cvt_pk_bf16(v1[2], v1[3]);
                        *(u32x4*)(rowp + bj * HALF) = w;
                    }
                }
        }
    }
};
struct EpiMerge {
    static constexpr bool PERM = true, AFTER_DRAIN = false, HOOK = true;
    bf16_t* O; int ldc; const bf16_t* G; int ldg;
    __device__ __forceinline__ void hook(f32x4 (&acc)[2][2][4][2], const Unit& u, int br, int wr, int wc, int fr, int fq) const {
        const int row0 = u.pm * BM + wr * 64 + fr, col0 = u.pn * BM + wc * 32 + 8 * fq;
        u32x4 rr[2][4][2];
#pragma unroll
        for (int ai = 0; ai < 2; ++ai)
#pragma unroll
            for (int m = 0; m < 4; ++m) {
                const bf16_t* gp = G + (size_t)(row0 + ai * HALF + m * 16) * ldg + col0 + 1024 * (br - 1);
#pragma unroll
                for (int bj = 0; bj < 2; ++bj) rr[ai][m][bj] = __builtin_nontemporal_load((const u32x4*)(gp + bj * HALF));
            }
#pragma unroll
        for (int ai = 0; ai < 2; ++ai)
#pragma unroll
            for (int m = 0; m < 4; ++m)
#pragma unroll
                for (int bj = 0; bj < 2; ++bj) {
                    const u32x4 q = rr[ai][m][bj];
                    acc[ai][bj][m][0] = acc[ai][bj][m][0] * (f32x4){bflo(q.x), bfhi(q.x), bflo(q.y), bfhi(q.y)};
                    acc[ai][bj][m][1] = acc[ai][bj][m][1] * (f32x4){bflo(q.z), bfhi(q.z), bflo(q.w), bfhi(q.w)};
                }
        asm volatile("" ::: "memory");
    }
    __device__ __forceinline__ void operator()(const f32x4 (&acc)[2][2][4][2], const Unit& u, int wr, int wc, int fr, int fq) const {
        const int row0 = u.pm * BM + wr * 64 + fr, col0 = u.pn * BM + wc * 32 + 8 * fq;
#pragma unroll
        for (int ai = 0; ai < 2; ++ai) {
            u32x4 gc[4][2];
#pragma unroll
            for (int m = 0; m < 4; ++m)
#pragma unroll
                for (int bj = 0; bj < 2; ++bj) gc[m][bj] = *(const u32x4*)(G + (size_t)(row0 + ai * HALF + m * 16) * ldg + col0 + 3072 + bj * HALF);
#pragma unroll
            for (int m = 0; m < 4; ++m) {
                bf16_t* rowp = O + (size_t)(row0 + ai * HALF + m * 16) * ldc + col0;
#pragma unroll
                for (int bj = 0; bj < 2; ++bj) {
                    const u32x4 c = gc[m][bj];
                    const f32x4 a0 = acc[ai][bj][m][0], a1 = acc[ai][bj][m][1];
                    u32x4 w; w.x = cvt_pk_bf16(a0[0] * bflo(c.x), a0[1] * bfhi(c.x)); w.y = cvt_pk_bf16(a0[2] * bflo(c.y), a0[3] * bfhi(c.y));
                    w.z = cvt_pk_bf16(a1[0] * bflo(c.z), a1[1] * bfhi(c.z)); w.w = cvt_pk_bf16(a1[2] * bflo(c.w), a1[3] * bfhi(c.w));
                    *(u32x4*)(rowp + bj * HALF) = w;
                }
            }
            asm volatile("" ::: "memory");
        }
    }
};
template <class Epi, class Sched, bool ALIGN_EPI = false, bool SP2 = false>
__device__ __forceinline__ void gemm_phase(PG8_LAS unsigned char* lds, const Gemm g, const Sched& S, const Epi& E) {
    int tid_ = threadIdx.x; asm volatile("" : "+v"(tid_));
    const int tid = tid_, wid = __builtin_amdgcn_readfirstlane(tid >> 6), lane = tid & 63, wr = wid >> 2, wc = wid & 3, fr = lane & 15, fq = lane >> 4;
    const int K = g.K, nt = K / BK;
    unsigned voffA[2], voffB[2];
#pragma unroll
    for (int i = 0; i < 2; ++i) { int R, C; stage_rc(tid * 16 + i * 8192, R, C); const int Rb = Epi::PERM ? ((R & ~31) + perm32(R & 31)) : R;
        voffA[i] = (unsigned)(R * K + C) * 2u; voffB[i] = (unsigned)(Rb * K + C) * 2u; }
    const size_t kstep = (size_t)(BK * 2);
    const size_t hstep = (size_t)HALF * K * 2;
    const size_t tstep = 2 * hstep;
    const unsigned ldsw = (unsigned)wid * 1024u;
    const int aoff = lds_byte(wr * 64 + fr, fq * 8), boff = lds_byte(wc * 32 + fr, fq * 8);
#define PG8_SA(b, h) (((b) * 2 + (h)) * HTB)
#define PG8_SB(b, h) ((4 + (b) * 2 + (h)) * HTB)
#define PG8_STAGE(bufoff, gbase, voff) do { _Pragma("unroll") for (int _i = 0; _i < 2; ++_i) \
        __builtin_amdgcn_global_load_lds((const unsigned*)((const char*)(gbase) + (voff)[_i]), (PG8_LAS unsigned*)(lds + (bufoff) + ldsw + _i * 8192), 16, 0, 0); } while (0)
#define PG8_LDA(dst, b, h) do { _Pragma("unroll") for (int m = 0; m < 4; ++m) _Pragma("unroll") for (int k = 0; k < 2; ++k) dst[m][k] = *(const PG8_LAS bf16x8*)(lds + PG8_SA(b, h) + aoff + m * 2048 + k * 1024); } while (0)
#define PG8_LDB(dst, b, h) do { _Pragma("unroll") for (int n = 0; n < 2; ++n) _Pragma("unroll") for (int k = 0; k < 2; ++k) dst[n][k] = *(const PG8_LAS bf16x8*)(lds + PG8_SB(b, h) + boff + n * 2048 + k * 1024); } while (0)
#define PG8_MMA(ai, bj, At, Bt) do { __builtin_amdgcn_s_setprio(1); _Pragma("unroll") for (int m = 0; m < 4; ++m) _Pragma("unroll") for (int n = 0; n < 2; ++n) _Pragma("unroll") for (int k = 0; k < 2; ++k) \
        acc[ai][bj][m][n] = __builtin_amdgcn_mfma_f32_16x16x32_bf16(Bt[n][k], At[m][k], acc[ai][bj][m][n], 0, 0, 0); __builtin_amdgcn_s_setprio(0); } while (0)
#define PG8_WAIT_V(n) asm volatile("s_waitcnt vmcnt(" #n ")" ::: "memory")
#define PG8_WAIT_L(n) asm volatile("s_waitcnt lgkmcnt(" #n ")" ::: "memory")
#define PG8_BAR __builtin_amdgcn_s_barrier()
#define PG8_SCHED __builtin_amdgcn_sched_barrier(0)
    Unit cur, nxt; int ui = 0;
    if (!S.next(0, cur)) return;
    f32x4 acc[2][2][4][2];
#pragma unroll
    for (int a = 0; a < 2; ++a)
#pragma unroll
        for (int b = 0; b < 2; ++b)
#pragma unroll
            for (int m = 0; m < 4; ++m)
#pragma unroll
                for (int n = 0; n < 2; ++n) acc[a][b][m][n] = (f32x4){0.f, 0.f, 0.f, 0.f};
    bf16x8 At[4][2], B0[2][2], B1[2][2];
    const char* cA = (const char*)g.A + (size_t)cur.pm * tstep; const char* cB = (const char*)g.Bt + (size_t)cur.pn * tstep;
    S.a_ready(cur);
    if constexpr (SP2) {
        PG8_STAGE(PG8_SB(0, 0), cB, voffB); PG8_STAGE(PG8_SB(0, 1), cB + hstep, voffB); PG8_STAGE(PG8_SA(0, 0), cA, voffA); PG8_STAGE(PG8_SA(0, 1), cA + hstep, voffA);
        if (wr == 1) PG8_BAR;
        PG8_WAIT_V(2); PG8_BAR;
        PG8_STAGE(PG8_SB(1, 0), cB + kstep, voffB); PG8_STAGE(PG8_SA(1, 0), cA + kstep, voffA); PG8_STAGE(PG8_SB(1, 1), cB + hstep + kstep, voffB);
        PG8_WAIT_V(6); PG8_BAR;
    } else {
        PG8_STAGE(PG8_SB(0, 0), cB, voffB); PG8_STAGE(PG8_SA(0, 0), cA, voffA); PG8_STAGE(PG8_SB(0, 1), cB + hstep, voffB); PG8_STAGE(PG8_SA(0, 1), cA + hstep, voffA);
        if (wr == 1) PG8_BAR;
        PG8_WAIT_V(4); PG8_BAR;
        PG8_STAGE(PG8_SB(1, 0), cB + kstep, voffB); PG8_STAGE(PG8_SA(1, 0), cA + kstep, voffA); PG8_STAGE(PG8_SB(1, 1), cB + hstep + kstep, voffB);
        PG8_WAIT_V(6); PG8_BAR;
    }
    for (;;) {
        const bool has_next = S.next(ui + 1, nxt);
        const char* nA = has_next ? (const char*)g.A + (size_t)nxt.pm * tstep : cA; const char* nB = has_next ? (const char*)g.Bt + (size_t)nxt.pn * tstep : cB;
        for (int t = 0; t < nt; t += 2) {
            if constexpr (Epi::HOOK) { if (t == 4 || t == 8 || t == 12) E.hook(acc, cur, t >> 2, wr, wc, fr, fq); }
            const bool last = (t == nt - 2);
            const char* a1 = cA + (size_t)(t + 1) * kstep;
            const char* a2 = last ? nA : cA + (size_t)(t + 2) * kstep; const char* b2 = last ? nB : cB + (size_t)(t + 2) * kstep;
            const char* a3 = a2 + kstep; const char* b3 = b2 + kstep;
            if (last && has_next) S.a_ready(nxt);
            if constexpr (SP2) {
            PG8_LDB(B0, 0, 0); PG8_LDB(B1, 0, 1); PG8_SCHED; PG8_LDA(At, 0, 0); PG8_STAGE(PG8_SA(1, 1), a1 + hstep, voffA);
            PG8_WAIT_V(8); PG8_WAIT_L(0); PG8_BAR; PG8_MMA(0, 0, At, B0); PG8_MMA(0, 1, At, B1); PG8_BAR; PG8_SCHED;
            PG8_LDA(At, 0, 1); PG8_STAGE(PG8_SB(0, 0), b2, voffB); PG8_STAGE(PG8_SB(0, 1), b2 + hstep, voffB); PG8_STAGE(PG8_SA(0, 0), a2, voffA);
            PG8_WAIT_V(8); PG8_WAIT_L(0); PG8_BAR; PG8_MMA(1, 0, At, B0); PG8_MMA(1, 1, At, B1); PG8_BAR; PG8_SCHED;
            PG8_LDB(B0, 1, 0); PG8_LDB(B1, 1, 1); PG8_SCHED; PG8_LDA(At, 1, 0); PG8_STAGE(PG8_SA(0, 1), a2 + hstep, voffA);
            PG8_WAIT_V(8); PG8_WAIT_L(0); PG8_BAR; PG8_MMA(0, 0, At, B0); PG8_MMA(0, 1, At, B1); PG8_BAR; PG8_SCHED;
            PG8_LDA(At, 1, 1); PG8_STAGE(PG8_SB(1, 0), b3, voffB); PG8_STAGE(PG8_SB(1, 1), b3 + hstep, voffB); PG8_STAGE(PG8_SA(1, 0), a3, voffA);
            PG8_WAIT_V(8); PG8_WAIT_L(0); PG8_BAR; PG8_MMA(1, 0, At, B0); PG8_MMA(1, 1, At, B1); PG8_BAR; PG8_SCHED;
            } else {
            PG8_LDB(B0, 0, 0); PG8_SCHED; PG8_LDA(At, 0, 0); PG8_STAGE(PG8_SA(1, 1), a1 + hstep, voffA);
            PG8_WAIT_L(8); PG8_BAR; PG8_WAIT_L(0); PG8_MMA(0, 0, At, B0); PG8_BAR; PG8_SCHED;
            PG8_LDB(B1, 0, 1); PG8_STAGE(PG8_SB(0, 0), b2, voffB);
            PG8_BAR; PG8_WAIT_L(0); PG8_MMA(0, 1, At, B1); PG8_BAR;
            PG8_LDA(At, 0, 1); PG8_STAGE(PG8_SA(0, 0), a2, voffA);
            PG8_BAR; PG8_WAIT_L(0); PG8_MMA(1, 0, At, B0); PG8_BAR; PG8_SCHED;
            PG8_STAGE(PG8_SB(0, 1), b2 + hstep, voffB);
            PG8_WAIT_V(6); PG8_BAR; PG8_MMA(1, 1, At, B1); PG8_BAR;
            PG8_LDB(B0, 1, 0); PG8_SCHED; PG8_LDA(At, 1, 0); PG8_STAGE(PG8_SA(0, 1), a2 + hstep, voffA);
            PG8_WAIT_L(8); PG8_BAR; PG8_WAIT_L(0); PG8_MMA(0, 0, At, B0); PG8_BAR; PG8_SCHED;
            PG8_LDB(B1, 1, 1); PG8_STAGE(PG8_SB(1, 0), b3, voffB);
            PG8_BAR; PG8_WAIT_L(0); PG8_MMA(0, 1, At, B1); PG8_BAR;
            PG8_LDA(At, 1, 1); PG8_STAGE(PG8_SA(1, 0), a3, voffA);
            PG8_BAR; PG8_WAIT_L(0); PG8_MMA(1, 0, At, B0); PG8_BAR; PG8_SCHED;
            PG8_STAGE(PG8_SB(1, 1), b3 + hstep, voffB);
            PG8_WAIT_V(6); PG8_BAR; PG8_MMA(1, 1, At, B1); PG8_BAR;
            }
        }
        if constexpr (ALIGN_EPI) { if (wr == 0) PG8_BAR; }
        if constexpr (!Epi::AFTER_DRAIN) { E(acc, cur, wr, wc, fr, fq); S.done(cur); }
        if (!has_next) break;
#pragma unroll
        for (int a = 0; a < 2; ++a)
#pragma unroll
            for (int b = 0; b < 2; ++b)
#pragma unroll
                for (int m = 0; m < 4; ++m)
#pragma unroll
                    for (int n = 0; n < 2; ++n) acc[a][b][m][n] = (f32x4){0.f, 0.f, 0.f, 0.f};
        cur = nxt; cA = nA; cB = nB; ++ui;
        if constexpr (ALIGN_EPI) { if (wr == 1) PG8_BAR; }
    }
    PG8_WAIT_V(0);
    if constexpr (!ALIGN_EPI) { if (wr == 0) PG8_BAR; }
    PG8_BAR;
    if constexpr (Epi::AFTER_DRAIN) { E.fused(acc, cur, wr, wc, fr, fq, lds, wid, lane); S.done(cur); }
#undef PG8_SA
#undef PG8_SB
#undef PG8_STAGE
#undef PG8_LDA
#undef PG8_LDB
#undef PG8_MMA
#undef PG8_WAIT_V
#undef PG8_WAIT_L
#undef PG8_BAR
#undef PG8_SCHED
}
}

#define LAS __attribute__((address_space(3)))
typedef unsigned short bf16_t;
typedef short bf16x8 __attribute__((ext_vector_type(8)));
typedef float f32x4 __attribute__((ext_vector_type(4)));
typedef float f32x16 __attribute__((ext_vector_type(16)));
typedef unsigned u32x4 __attribute__((ext_vector_type(4)));
typedef unsigned u32x2 __attribute__((ext_vector_type(2)));
using pg8::bflo; using pg8::bfhi; using pg8::sigmoid_f; using pg8::cvt_pk_bf16;

constexpr int DM = 1024, NB = 32, SEQ = 2048, DEPTH = 4, M = NB * SEQ, FF = 2816, NIN = 6916, NPROJ = 6912, PLE = 256, YW = 1280;
constexpr int MH = M / 2;
constexpr float EPS = 1e-6f, LOG2E = 1.4426950408889634f, QSCALE = 0.125f * 1.4426950408889634f, NEGBIG = -1e30f;
constexpr int NWAVES = 8, NTHREADS = 512;
constexpr int LDS_BYTES = 147456;
constexpr int PH_PER_LAYER = 17, N_PHASES = PH_PER_LAYER * DEPTH;

constexpr size_t MiB = 1u << 20;
constexpr size_t WS_W = 1 * MiB, WS_CTL_BAR = 16384, CTL_ZERO_BYTES = 65536;
constexpr size_t W_GU1 = WS_W, W_D1 = W_GU1 + (size_t)2 * FF * DM * 2, W_IN = W_D1 + (size_t)DM * FF * 2, W_BR = W_IN + (size_t)NPROJ * DM * 2, W_O = W_BR + (size_t)DM * YW * 2,
                 W_GU2 = W_O + (size_t)DM * DM * 2, W_D2 = W_GU2 + (size_t)2 * FF * DM * 2, W_PG = W_D2 + (size_t)DM * FF * 2, W_PLE = W_PG + (size_t)DM * DM * 2, W_AF = W_PLE + (size_t)DM * PLE * 2, W_END = W_AF + 16384;
static_assert(W_END <= 58 * MiB, "weights region");
constexpr size_t WS_U = 64 * MiB, WS_HID = 192 * MiB, WS_F = 544 * MiB, WS_PROJ = 192 * MiB, WS_YCAT = 624 * MiB, WS_MERGED = 800 * MiB, WS_LOGF = 928 * MiB, WS_CUM = 929 * MiB, WS_PBF = 930 * MiB, WS_F2 = 192 * MiB, WS_WB = 962 * MiB, WS_NEED = 1020 * MiB;
static_assert(WS_PROJ + (size_t)MH * NPROJ * 2 <= WS_YCAT && WS_YCAT + (size_t)M * YW * 2 <= WS_MERGED && WS_MERGED + (size_t)M * DM * 2 <= WS_LOGF && WS_HID + (size_t)M * FF * 2 <= WS_F && WS_F + (size_t)M * DM * 4 <= WS_MERGED && WS_PBF + (size_t)M * PLE * 2 <= WS_NEED && WS_F2 + (size_t)M * DM * 4 <= WS_F, "ws map");

#define CAS __attribute__((address_space(4)))
struct Args { const float* in[31]; float* out; unsigned char* ws; int ph_lo, ph_hi; unsigned char bucket[128]; };

template <int CTRL> __device__ __forceinline__ float dpp_f(float v) { return __builtin_bit_cast(float, __builtin_amdgcn_update_dpp(0, __builtin_bit_cast(int, v), CTRL, 0xf, 0xf, false)); }
__device__ __forceinline__ float wave_sum(float v) {
    v += dpp_f<0xB1>(v);
    v += dpp_f<0x4E>(v);
    v += dpp_f<0x141>(v);
    v += dpp_f<0x140>(v);
    const int b = __builtin_bit_cast(int, v);
    const float r0 = __builtin_bit_cast(float, __builtin_amdgcn_readlane(b, 0)), r1 = __builtin_bit_cast(float, __builtin_amdgcn_readlane(b, 16));
    const float r2 = __builtin_bit_cast(float, __builtin_amdgcn_readlane(b, 32)), r3 = __builtin_bit_cast(float, __builtin_amdgcn_readlane(b, 48));
    return (r0 + r1) + (r2 + r3);
}
__device__ __forceinline__ unsigned f2bf(float f) { unsigned u = __builtin_bit_cast(unsigned, f); return (u + 0x7fffu + ((u >> 16) & 1u)) >> 16; }
__device__ __forceinline__ unsigned pk2(float lo, float hi) { return f2bf(lo) | (f2bf(hi) << 16); }

__device__ __forceinline__ void transpose_item(const float* W, int ldn, int k0, int srccol  , bf16_t* WT, int ldk, int dst_row0, int dst_k0, LAS float* scr, int lane) {
#pragma unroll 8
    for (int i = 0; i < 32; ++i) { const int kk = 2 * i + (lane >> 5); scr[kk * 33 + (lane & 31)] = W[(size_t)(k0 + kk) * ldn + srccol]; }
    asm volatile("s_waitcnt lgkmcnt(0)" ::: "memory");
    const int c = lane & 7;
#pragma unroll
    for (int j = 0; j < 4; ++j) { const int n = (lane >> 3) + 8 * j; const LAS float* s = scr + (8 * c) * 33 + n;
        u32x4 o; o.x = pk2(s[0 * 33], s[1 * 33]); o.y = pk2(s[2 * 33], s[3 * 33]); o.z = pk2(s[4 * 33], s[5 * 33]); o.w = pk2(s[6 * 33], s[7 * 33]);
        *(u32x4*)(WT + (size_t)(dst_row0 + n) * ldk + dst_k0 + 8 * c) = o; }
    asm volatile("s_waitcnt lgkmcnt(0)" ::: "memory");
}
__device__ __forceinline__ void transpose_matrix_item(const float* W, int K, int ldn, int Ndst, int mode, bf16_t* WT, int ldk, int dst_k0, LAS float* scr, int item, int lane) {
    const int nnb = Ndst / 32, kb = item / nnb, nb = item % nnb, n0 = nb * 32;
    const int j = lane & 31; int src;
    if (mode == 1) { const int t = n0 >> 8, r = n0 & 255; src = ((r < 128) ? (128 * t + r) : (FF + 128 * t + (r - 128))) + j; }
    else if (mode == 2) {
        if (n0 < 2816) src = n0 + (n0 >= 768 ? 4 : 0) + j;
        else {
            const int gl = n0 - 2816, T = gl >> 8, l0 = gl & 255, bj = l0 >> 7, wc = (l0 >> 5) & 3, fq = j >> 3, n = (j >> 2) & 1, e = j & 3;
            src = 2820 + 1024 * (2 * bj + n) + 64 * T + 16 * wc + 4 * fq + e;
        }
    }
    else src = n0 + j;
    transpose_item(W, ldn, kb * 64, src, WT, ldk, n0, dst_k0 + kb * 64, scr, lane);
}
__device__ __forceinline__ void wconv_phase(const CAS Args* a, int L, int part, LAS unsigned char* lds, int gw, int NGW, int wave, int lane) {
    LAS float* scr = (LAS float*)(lds + wave * 16384);
    unsigned char* ws = a->ws + ((L & 1) ? WS_WB - WS_W : 0);
    const float* gu1 = a->in[3] + (size_t)L * DM * 2 * FF; const float* d1 = a->in[4] + (size_t)L * FF * DM; const float* win = a->in[7] + (size_t)L * DM * NIN;
    const float* bra = a->in[17] + (size_t)L * 256 * DM; const float* brb = a->in[18] + (size_t)L * 256 * DM; const float* brc = a->in[19] + (size_t)L * 256 * DM; const float* brd = a->in[20] + (size_t)L * 512 * DM;
    const float* wo = a->in[21] + (size_t)L * DM * DM; const float* gu2 = a->in[24] + (size_t)L * DM * 2 * FF; const float* d2 = a->in[25] + (size_t)L * FF * DM;
    const float* wpg = a->in[28] + (size_t)L * DM * DM; const float* wple = a->in[29] + (size_t)L * PLE * DM;
    constexpr int I_GU = (DM / 64) * (2 * FF / 32), I_D = (FF / 64) * (DM / 32), I_IN = (DM / 64) * (NPROJ / 32), I_BR = (256 / 64) * (DM / 32), I_BRD = (512 / 64) * (DM / 32), I_SQ = (DM / 64) * (DM / 32), I_PLE = (PLE / 64) * (DM / 32);
    constexpr int NITEMS = 2 * I_GU + 2 * I_D + I_IN + 3 * I_BR + I_BRD + 2 * I_SQ + I_PLE;
    const int it_lo = (part == 1) ? NITEMS / 2 : 0, it_hi = (part == 0) ? NITEMS / 2 : NITEMS;
    for (int it = it_lo + gw; it < it_hi; it += NGW) {
        int r = it;
        if (r < I_GU) { transpose_matrix_item(gu1, DM, 2 * FF, 2 * FF, 1, (bf16_t*)(ws + W_GU1), DM, 0, scr, r, lane); continue; } r -= I_GU;
        if (r < I_GU) { transpose_matrix_item(gu2, DM, 2 * FF, 2 * FF, 1, (bf16_t*)(ws + W_GU2), DM, 0, scr, r, lane); continue; } r -= I_GU;
        if (r < I_D) { transpose_matrix_item(d1, FF, DM, DM, 0, (bf16_t*)(ws + W_D1), FF, 0, scr, r, lane); continue; } r -= I_D;
        if (r < I_D) { transpose_matrix_item(d2, FF, DM, DM, 0, (bf16_t*)(ws + W_D2), FF, 0, scr, r, lane); continue; } r -= I_D;
        if (r < I_IN) { transpose_matrix_item(win, DM, NIN, NPROJ, 2, (bf16_t*)(ws + W_IN), DM, 0, scr, r, lane); continue; } r -= I_IN;
        if (r < I_BR) { transpose_matrix_item(bra, 256, DM, DM, 0, (bf16_t*)(ws + W_BR), YW, 0, scr, r, lane); continue; } r -= I_BR;
        if (r < I_BR) { transpose_matrix_item(brb, 256, DM, DM, 0, (bf16_t*)(ws + W_BR), YW, 256, scr, r, lane); continue; } r -= I_BR;
        if (r < I_BR) { transpose_matrix_item(brc, 256, DM, DM, 0, (bf16_t*)(ws + W_BR), YW, 512, scr, r, lane); continue; } r -= I_BR;
        if (r < I_BRD) { transpose_matrix_item(brd, 512, DM, DM, 0, (bf16_t*)(ws + W_BR), YW, 768, scr, r, lane); continue; } r -= I_BRD;
        if (r < I_SQ) { transpose_matrix_item(wo, DM, DM, DM, 0, (bf16_t*)(ws + W_O), DM, 0, scr, r, lane); continue; } r -= I_SQ;
        if (r < I_SQ) { transpose_matrix_item(wpg, DM, DM, DM, 0, (bf16_t*)(ws + W_PG), DM, 0, scr, r, lane); continue; } r -= I_SQ;
        transpose_matrix_item(wple, PLE, DM, DM, 0, (bf16_t*)(ws + W_PLE), PLE, 0, scr, r, lane);
    }
    float* af = (float*)(ws + W_AF);
    if (part != 1) for (int i = gw * 64 + lane; i < DM * 4; i += NGW * 64) af[i] = win[(size_t)(i >> 2) * NIN + 768 + (i & 3)];
}

__device__ __forceinline__ float log_sigmoid_f(float x) { return fminf(x, 0.f) - log1pf(expf(-fabsf(x))); }
typedef _Float16 h16x2 __attribute__((ext_vector_type(2)));
__device__ __forceinline__ unsigned pkh(float a, float b) { h16x2 v; v.x = (_Float16)a; v.y = (_Float16)b; return __builtin_bit_cast(unsigned, v); }
__device__ __forceinline__ float hlo(unsigned w) { return (float)__builtin_bit_cast(h16x2, w).x; }
__device__ __forceinline__ float hhi(unsigned w) { return (float)__builtin_bit_cast(h16x2, w).y; }
struct RowArgs { const float* hin32; const unsigned short* hin16; float* hout32; unsigned short* hout16; const bf16_t* F; const bf16_t* F2; const float* gpost; float scale; const float* gnext; bf16_t* U; const float* AF; const float* bforget; float* LOGF; const float* p; bf16_t* Pbf; };
struct RowRaw { f32x4 v32[2][2]; u32x4 v16[2]; u32x4 f[2]; u32x4 e[2]; f32x4 p; };
__device__ __forceinline__ void row_load(const RowArgs& R, int m, int lane, RowRaw& q) {
    const size_t off = (size_t)m * DM + 8 * lane;
    if (R.hin32) {
#pragma unroll
        for (int j = 0; j < 2; ++j) { q.v32[j][0] = __builtin_nontemporal_load((const f32x4*)(R.hin32 + off + 512 * j)); q.v32[j][1] = __builtin_nontemporal_load((const f32x4*)(R.hin32 + off + 512 * j + 4)); }
    } else {
#pragma unroll
        for (int j = 0; j < 2; ++j) q.v16[j] = __builtin_nontemporal_load((const u32x4*)(R.hin16 + off + 512 * j));
    }
    if (R.F) {
#pragma unroll
        for (int j = 0; j < 2; ++j) q.f[j] = __builtin_nontemporal_load((const u32x4*)(R.F + off + 512 * j));
    }
    if (R.F2) {
#pragma unroll
        for (int j = 0; j < 2; ++j) q.e[j] = __builtin_nontemporal_load((const u32x4*)(R.F2 + off + 512 * j));
    }
    if (R.p) q.p = __builtin_nontemporal_load((const f32x4*)(R.p + (size_t)m * PLE + 4 * lane));
}
#define UNPK_BF(dst, SRC_) do { const u32x4 t_ = (SRC_); dst[0] = bflo(t_.x); dst[1] = bfhi(t_.x); dst[2] = bflo(t_.y); dst[3] = bfhi(t_.y); dst[4] = bflo(t_.z); dst[5] = bfhi(t_.z); dst[6] = bflo(t_.w); dst[7] = bfhi(t_.w); } while (0)
__device__ __forceinline__ void row_process(const RowArgs& R, int m, int lane, const RowRaw& q, const float (&gp)[2][8], const float (&gn)[2][8], const f32x4 bf) {
    const size_t off = (size_t)m * DM + 8 * lane;
    float v[2][8];
    if (R.hin32) {
#pragma unroll
        for (int j = 0; j < 2; ++j)
#pragma unroll
            for (int e = 0; e < 4; ++e) { v[j][e] = q.v32[j][0][e]; v[j][4 + e] = q.v32[j][1][e]; }
    } else {
#pragma unroll
        for (int j = 0; j < 2; ++j) { const u32x4 w = q.v16[j]; v[j][0] = hlo(w.x); v[j][1] = hhi(w.x); v[j][2] = hlo(w.y); v[j][3] = hhi(w.y); v[j][4] = hlo(w.z); v[j][5] = hhi(w.z); v[j][6] = hlo(w.w); v[j][7] = hhi(w.w); }
    }
    if (R.F) {
        float f[2][8];
#pragma unroll
        for (int j = 0; j < 2; ++j) UNPK_BF(f[j], q.f[j]);
        if (R.F2) {
            float e[2][8]; float ss = 0.f;
#pragma unroll
            for (int j = 0; j < 2; ++j) { UNPK_BF(e[j], q.e[j]);
#pragma unroll
                for (int c = 0; c < 8; ++c) ss += e[j][c] * e[j][c]; }
            const float r = 1.0f / sqrtf(wave_sum(ss) * (1.0f / DM) + EPS);
#pragma unroll
            for (int j = 0; j < 2; ++j)
#pragma unroll
                for (int c = 0; c < 8; ++c) v[j][c] += (1.0f / (1.0f + expf(-f[j][c]))) * (e[j][c] * r * gp[j][c]);
        } else {
            float ss = 0.f;
#pragma unroll
            for (int j = 0; j < 2; ++j)
#pragma unroll
                for (int c = 0; c < 8; ++c) ss += f[j][c] * f[j][c];
            const float r = 1.0f / sqrtf(wave_sum(ss) * (1.0f / DM) + EPS);
#pragma unroll
            for (int j = 0; j < 2; ++j)
#pragma unroll
                for (int c = 0; c < 8; ++c) v[j][c] += R.scale * ((f[j][c] * r) * gp[j][c]);
        }
        if (R.hout32) {
#pragma unroll
            for (int j = 0; j < 2; ++j) { __builtin_nontemporal_store((f32x4){v[j][0], v[j][1], v[j][2], v[j][3]}, (f32x4*)(R.hout32 + off + 512 * j)); __builtin_nontemporal_store((f32x4){v[j][4], v[j][5], v[j][6], v[j][7]}, (f32x4*)(R.hout32 + off + 512 * j + 4)); }
        } else {
#pragma unroll
            for (int j = 0; j < 2; ++j) {
                u32x4 w; w.x = pkh(v[j][0], v[j][1]); w.y = pkh(v[j][2], v[j][3]); w.z = pkh(v[j][4], v[j][5]); w.w = pkh(v[j][6], v[j][7]);
                __builtin_nontemporal_store(w, (u32x4*)(R.hout16 + off + 512 * j));
                v[j][0] = hlo(w.x); v[j][1] = hhi(w.x); v[j][2] = hlo(w.y); v[j][3] = hhi(w.y); v[j][4] = hlo(w.z); v[j][5] = hhi(w.z); v[j][6] = hlo(w.w); v[j][7] = hhi(w.w);
            }
        }
    }
    if (R.gnext) {
        float ss = 0.f;
#pragma unroll
        for (int j = 0; j < 2; ++j)
#pragma unroll
            for (int c = 0; c < 8; ++c) ss += v[j][c] * v[j][c];
        const float r2 = 1.0f / sqrtf(wave_sum(ss) * (1.0f / DM) + EPS);
        float un[2][8];
#pragma unroll
        for (int j = 0; j < 2; ++j) {
#pragma unroll
            for (int c = 0; c < 8; ++c) un[j][c] = (v[j][c] * r2) * gn[j][c];
            u32x4 w; w.x = pk2(un[j][0], un[j][1]); w.y = pk2(un[j][2], un[j][3]); w.z = pk2(un[j][4], un[j][5]); w.w = pk2(un[j][6], un[j][7]);
            *(u32x4*)(R.U + off + 512 * j) = w;
        }
        if (R.AF) {
            f32x4 acc = {0.f, 0.f, 0.f, 0.f};
#pragma unroll
            for (int j = 0; j < 2; ++j)
#pragma unroll
                for (int c = 0; c < 8; ++c) acc = acc + un[j][c] * *(const f32x4*)(R.AF + (size_t)(8 * lane + 512 * j + c) * 4);
            acc[0] = wave_sum(acc[0]); acc[1] = wave_sum(acc[1]); acc[2] = wave_sum(acc[2]); acc[3] = wave_sum(acc[3]);
            if (lane == 0) { f32x4 o; o[0] = log_sigmoid_f(acc[0] + bf[0]); o[1] = log_sigmoid_f(acc[1] + bf[1]); o[2] = log_sigmoid_f(acc[2] + bf[2]); o[3] = log_sigmoid_f(acc[3] + bf[3]); *(f32x4*)(R.LOGF + (size_t)m * 4) = o; }
        }
    }
    if (R.p) { u32x2 w; w.x = pk2(q.p[0], q.p[1]); w.y = pk2(q.p[2], q.p[3]); *(u32x2*)(R.Pbf + (size_t)m * PLE + 4 * lane) = w; }
}
__device__ __forceinline__ void row_pass(const RowArgs& R, int gw, int NGW, int lane) {
    float gp[2][8], gn[2][8];
#pragma unroll
    for (int j = 0; j < 2; ++j)
#pragma unroll
        for (int h = 0; h < 2; ++h) {
            const f32x4 a = R.gpost ? *(const f32x4*)(R.gpost + 8 * lane + 512 * j + 4 * h) : (f32x4){0.f, 0.f, 0.f, 0.f};
            const f32x4 b = R.gnext ? *(const f32x4*)(R.gnext + 8 * lane + 512 * j + 4 * h) : (f32x4){0.f, 0.f, 0.f, 0.f};
#pragma unroll
            for (int e = 0; e < 4; ++e) { gp[j][4 * h + e] = a[e]; gn[j][4 * h + e] = b[e]; }
        }
    const f32x4 bf = R.AF ? *(const f32x4*)R.bforget : (f32x4){0.f, 0.f, 0.f, 0.f};
    RowRaw qa, qb;
    if (gw < M) row_load(R, gw, lane, qa);
    for (int m = gw; m < M; m += 2 * NGW) {
        const int m1 = m + NGW, m2 = m + 2 * NGW;
        if (m1 < M) row_load(R, m1, lane, qb);
        row_process(R, m, lane, qa, gp, gn, bf);
        if (m2 < M) row_load(R, m2, lane, qa);
        if (m1 < M) row_process(R, m1, lane, qb, gp, gn, bf);
    }
}
__device__ __forceinline__ void cumsum_seq(const float* LOGF, float* CUM, int seq, int lane) {
    const int b = seq >> 2, h = seq & 3; const size_t base = ((size_t)b * SEQ + 32 * lane) * 4 + h;
    float s = 0.f;
#pragma unroll 8
    for (int i = 0; i < 32; ++i) s += LOGF[base + 4 * i];
    float incl = s;
#pragma unroll
    for (int o = 1; o < 64; o <<= 1) { const float n = __shfl_up(incl, o); if (lane >= o) incl += n; }
    float run = incl - s;
#pragma unroll 8
    for (int i = 0; i < 32; ++i) { run += LOGF[base + 4 * i]; CUM[base + 4 * i] = run * LOG2E; }
}

__device__ __forceinline__ int crow(int r, int hi) { return (r & 3) + 8 * (r >> 2) + 4 * hi; }
__device__ __forceinline__ int kvperm(int kv) { return (kv & 0x33) | (((kv >> 2) & 1) << 3) | (((kv >> 3) & 1) << 2); }
constexpr int KROW = 144;
template <int TYPE>
__device__ __forceinline__ void attn_tile(f32x16 (&o)[2], float& m, float& l, const bf16x8 (&qr)[4], const LAS unsigned char* Kt, const LAS unsigned char* VTt, int vt_stride,
                                          int kv0, int qpos, float cq, const LAS float* ckv, const LAS float* biasT, bool domask, int r32, int hi) {
    f32x16 p0, p1;
#pragma unroll
    for (int r = 0; r < 16; ++r) { p0[r] = 0.f; p1[r] = 0.f; }
    const LAS unsigned char* kp = Kt + r32 * KROW + 16 * hi;
#pragma unroll
    for (int d0 = 0; d0 < 4; ++d0) {
        const bf16x8 a0 = *(const LAS bf16x8*)(kp + 32 * d0), a1 = *(const LAS bf16x8*)(kp + 32 * KROW + 32 * d0);
        p0 = __builtin_amdgcn_mfma_f32_32x32x16_bf16(a0, qr[d0], p0, 0, 0, 0);
        p1 = __builtin_amdgcn_mfma_f32_32x32x16_bf16(a1, qr[d0], p1, 0, 0, 0);
    }
    if (TYPE == 0) {
#pragma unroll
        for (int g = 0; g < 4; ++g) {
            const f32x4 c0 = *(const LAS f32x4*)(ckv + 8 * g + 4 * hi), c1 = *(const LAS f32x4*)(ckv + 32 + 8 * g + 4 * hi);
#pragma unroll
            for (int e = 0; e < 4; ++e) { p0[4 * g + e] += cq - c0[e]; p1[4 * g + e] += cq - c1[e]; }
        }
        if (domask) {
#pragma unroll
            for (int r = 0; r < 16; ++r) { const int kv = kv0 + crow(r, hi); if (kv > qpos) p0[r] = NEGBIG; if (kv + 32 > qpos) p1[r] = NEGBIG; }
        }
    } else {
#pragma unroll
        for (int r = 0; r < 16; ++r) {
            const int d0 = qpos - (kv0 + crow(r, hi)), d1 = d0 - 32;
            const float b0 = biasT[d0 & 127], b1 = biasT[d1 & 127];
            p0[r] = ((unsigned)d0 < 128u) ? p0[r] + b0 : NEGBIG; p1[r] = ((unsigned)d1 < 128u) ? p1[r] + b1 : NEGBIG;
        }
    }
    float mx = fmaxf(p0[0], p1[0]);
#pragma unroll
    for (int r = 1; r < 16; ++r) mx = fmaxf(mx, fmaxf(p0[r], p1[r]));
    mx = fmaxf(mx, __shfl_xor(mx, 32));
    const float m_old = m, mn = fmaxf(m, mx), alpha = __builtin_amdgcn_exp2f(m - mn); m = mn;
    float s = 0.f;
#pragma unroll
    for (int r = 0; r < 16; ++r) { p0[r] = __builtin_amdgcn_exp2f(p0[r] - mn); p1[r] = __builtin_amdgcn_exp2f(p1[r] - mn); s += p0[r] + p1[r]; }
    l = l * alpha + s;
    if (__any(mn > m_old)) {
#pragma unroll
        for (int r = 0; r < 16; ++r) { o[0][r] *= alpha; o[1][r] *= alpha; }
    }
    bf16x8 pf[4];
    { u32x4 w;
      w.x = cvt_pk_bf16(p0[0], p0[1]); w.y = cvt_pk_bf16(p0[2], p0[3]); w.z = cvt_pk_bf16(p0[4], p0[5]); w.w = cvt_pk_bf16(p0[6], p0[7]); pf[0] = __builtin_bit_cast(bf16x8, w);
      w.x = cvt_pk_bf16(p0[8], p0[9]); w.y = cvt_pk_bf16(p0[10], p0[11]); w.z = cvt_pk_bf16(p0[12], p0[13]); w.w = cvt_pk_bf16(p0[14], p0[15]); pf[1] = __builtin_bit_cast(bf16x8, w);
      w.x = cvt_pk_bf16(p1[0], p1[1]); w.y = cvt_pk_bf16(p1[2], p1[3]); w.z = cvt_pk_bf16(p1[4], p1[5]); w.w = cvt_pk_bf16(p1[6], p1[7]); pf[2] = __builtin_bit_cast(bf16x8, w);
      w.x = cvt_pk_bf16(p1[8], p1[9]); w.y = cvt_pk_bf16(p1[10], p1[11]); w.z = cvt_pk_bf16(p1[12], p1[13]); w.w = cvt_pk_bf16(p1[14], p1[15]); pf[3] = __builtin_bit_cast(bf16x8, w); }
#pragma unroll
    for (int db = 0; db < 2; ++db) {
        const LAS unsigned char* vp = VTt + (32 * db + r32) * vt_stride + 16 * hi;
#pragma unroll
        for (int j = 0; j < 4; ++j) { const bf16x8 a = *(const LAS bf16x8*)(vp + 32 * j); o[db] = __builtin_amdgcn_mfma_f32_32x32x16_bf16(a, pf[j], o[db], 0, 0, 0); }
    }
}
__device__ __forceinline__ void attn_store(const f32x16 (&o)[2], float l, bf16_t* dst  , int hi) {
    const float lt = l + __shfl_xor(l, 32), inv = 1.0f / lt;
#pragma unroll
    for (int db = 0; db < 2; ++db)
#pragma unroll
        for (int g = 0; g < 4; ++g) { u32x2 w; w.x = cvt_pk_bf16(o[db][4 * g] * inv, o[db][4 * g + 1] * inv); w.y = cvt_pk_bf16(o[db][4 * g + 2] * inv, o[db][4 * g + 3] * inv);
            *(u32x2*)(dst + 32 * db + 8 * g + 4 * hi) = w; }
}

constexpr int AVS = 272, A_K = 0, A_VT = 128 * KROW, A_C = A_VT + 64 * AVS, ABUF = A_C + 512;
__device__ __forceinline__ void attnA_unit(LAS unsigned char* lds, const bf16_t* PROJ, const float* CUM, bf16_t* YCAT, int bg, int bl, int h, int qb, int tid, int wave, int lane) {
    const int r32 = lane & 31, hi = lane >> 5, NS = 2 * (qb + 1), q0w = 256 * qb + 32 * wave, qpos = q0w + r32;
    const size_t prow = (size_t)bl * SEQ, grow = (size_t)bg * SEQ;
    bf16x8 qr[4];
    { const bf16_t* qp = PROJ + (prow + qpos) * NPROJ + 64 * h + 8 * hi;
#pragma unroll
      for (int d0 = 0; d0 < 4; ++d0) qr[d0] = *(const bf16x8*)(qp + 16 * d0); }
    const float cq = CUM[(grow + qpos) * 4 + h];
    const int lrow = tid >> 3, lch = tid & 7;
    const bf16_t* kg = PROJ + (prow + lrow) * NPROJ + 256 + 64 * h + 8 * lch;
    const bf16_t* vg = PROJ + (prow + 2 * lane) * NPROJ + 512 + 64 * h + 8 * wave;
    const float* cgp = CUM + (grow + (tid & 127)) * 4 + h;
    const int kst = A_K + lrow * KROW + lch * 16;
    const int vpos = 64 * ((2 * lane) >> 6) + kvperm((2 * lane) & 63), vst = A_VT + (8 * wave) * AVS + vpos * 2;
    u32x4 k0, k1, va, vb; float creg = 0.f;
#define A_LOAD(st) do { const size_t ro = (size_t)(st) * 128 * NPROJ; k0 = *(const u32x4*)(kg + ro); k1 = *(const u32x4*)(kg + ro + (size_t)64 * NPROJ); \
        va = *(const u32x4*)(vg + ro); vb = *(const u32x4*)(vg + ro + NPROJ); if (tid < 128) creg = cgp[(size_t)(st) * 128 * 4]; } while (0)
#define A_STORE(buf) do { LAS unsigned char* bb = lds + (buf) * ABUF; *(LAS u32x4*)(bb + kst) = k0; *(LAS u32x4*)(bb + kst + 64 * KROW) = k1; \
        LAS unsigned* vv = (LAS unsigned*)(bb + vst); \
        vv[0 * (AVS / 4)] = (va.x & 0xffffu) | (vb.x << 16); vv[1 * (AVS / 4)] = (va.x >> 16) | (vb.x & 0xffff0000u); \
        vv[2 * (AVS / 4)] = (va.y & 0xffffu) | (vb.y << 16); vv[3 * (AVS / 4)] = (va.y >> 16) | (vb.y & 0xffff0000u); \
        vv[4 * (AVS / 4)] = (va.z & 0xffffu) | (vb.z << 16); vv[5 * (AVS / 4)] = (va.z >> 16) | (vb.z & 0xffff0000u); \
        vv[6 * (AVS / 4)] = (va.w & 0xffffu) | (vb.w << 16); vv[7 * (AVS / 4)] = (va.w >> 16) | (vb.w & 0xffff0000u); \
        if (tid < 128) *(LAS float*)(bb + A_C + 4 * tid) = creg; } while (0)
    f32x16 o[2];
#pragma unroll
    for (int r = 0; r < 16; ++r) { o[0][r] = 0.f; o[1][r] = 0.f; }
    float m = NEGBIG, l = 0.f;
    A_LOAD(0); A_STORE(0); __syncthreads();
    for (int st = 0; st < NS; ++st) {
        if (st + 1 < NS) A_LOAD(st + 1);
        const LAS unsigned char* bb = lds + (st & 1) * ABUF;
#pragma unroll
        for (int sub = 0; sub < 2; ++sub) {
            const int t = 2 * st + sub;
            if (64 * t <= q0w + 31)
                attn_tile<0>(o, m, l, qr, bb + A_K + sub * 64 * KROW, bb + A_VT + sub * 128, AVS, 64 * t, qpos, cq, (const LAS float*)(bb + A_C) + 64 * sub, (const LAS float*)0, 64 * t + 63 > q0w, r32, hi);
        }
        if (st + 1 < NS) A_STORE((st + 1) & 1);
        __syncthreads();
    }
#undef A_LOAD
#undef A_STORE
    attn_store(o, l, YCAT + (grow + qpos) * YW + 64 * h, hi);
}
constexpr int D_K = 0, D_VT = 4 * 64 * KROW, D_VSTRIDE = 528, D_BIAS = D_VT + 64 * D_VSTRIDE, D_END = D_BIAS + 4 * 128 * 4;
__device__ __forceinline__ void attnD_unit(LAS unsigned char* lds, const bf16_t* PROJ, bf16_t* YCAT, const float* relb, const float* sinks, const CAS unsigned char* bucket, int bg, int bl, int kvh, int n, int tid, int wave, int lane) {
    const int r32 = lane & 31, hi = lane >> 5;
    const size_t prow = (size_t)bl * SEQ, grow = (size_t)bg * SEQ;
#pragma unroll
    for (int it = 0; it < 4; ++it) {
        const int idx = tid + 512 * it, i = idx >> 3, ch = idx & 7, pos = 128 * (n - 1) + i;
        if (pos >= 0) *(LAS u32x4*)(lds + D_K + (i >> 6) * (64 * KROW) + (i & 63) * KROW + ch * 16) = *(const u32x4*)(PROJ + (prow + pos) * NPROJ + 2560 + 64 * kvh + 8 * ch);
    }
#pragma unroll
    for (int it = 0; it < 2; ++it) {
        const int i = 2 * (lane + 64 * it), pos = 128 * (n - 1) + i;
        if (pos >= 0) {
            const bf16_t* src = PROJ + (prow + pos) * NPROJ + 2688 + 64 * kvh + 8 * wave;
            const u32x4 va = *(const u32x4*)src, vb = *(const u32x4*)(src + NPROJ);
            LAS unsigned* vv = (LAS unsigned*)(lds + D_VT + (8 * wave) * D_VSTRIDE + ((i >> 6) * 64 + kvperm(i & 63)) * 2);
            vv[0 * (D_VSTRIDE / 4)] = (va.x & 0xffffu) | (vb.x << 16); vv[1 * (D_VSTRIDE / 4)] = (va.x >> 16) | (vb.x & 0xffff0000u);
            vv[2 * (D_VSTRIDE / 4)] = (va.y & 0xffffu) | (vb.y << 16); vv[3 * (D_VSTRIDE / 4)] = (va.y >> 16) | (vb.y & 0xffff0000u);
            vv[4 * (D_VSTRIDE / 4)] = (va.z & 0xffffu) | (vb.z << 16); vv[5 * (D_VSTRIDE / 4)] = (va.z >> 16) | (vb.z & 0xffff0000u);
            vv[6 * (D_VSTRIDE / 4)] = (va.w & 0xffffu) | (vb.w << 16); vv[7 * (D_VSTRIDE / 4)] = (va.w >> 16) | (vb.w & 0xffff0000u);
        }
    }
    { const int g = tid >> 7, dist = tid & 127; ((LAS float*)(lds + D_BIAS))[tid] = relb[(int)bucket[dist] * 8 + 4 * kvh + g] * LOG2E; }
    __syncthreads();
#pragma unroll 1
    for (int k = wave; k < 16; k += 8) {
        const int g = k >> 2, j = k & 3, hq = 4 * kvh + g, qpos = 128 * n + 32 * j + r32;
        bf16x8 qr[4];
        { const bf16_t* qp = PROJ + (prow + qpos) * NPROJ + 2048 + 64 * hq + 8 * hi;
#pragma unroll
          for (int d0 = 0; d0 < 4; ++d0) qr[d0] = *(const bf16x8*)(qp + 16 * d0); }
        f32x16 o[2];
#pragma unroll
        for (int r = 0; r < 16; ++r) { o[0][r] = 0.f; o[1][r] = 0.f; }
        float m = sinks[hq] * LOG2E, l = (hi == 0) ? 1.0f : 0.0f;
        int jlo = (j >= 2) ? 1 : 0; const int jhi = (j >= 2) ? 3 : 2; if (n == 0 && jlo < 2) jlo = 2;
        for (int jt = jlo; jt <= jhi; ++jt)
            attn_tile<1>(o, m, l, qr, lds + D_K + jt * (64 * KROW), lds + D_VT + jt * 128, D_VSTRIDE, 128 * (n - 1) + 64 * jt, qpos, 0.f, (const LAS float*)0, (const LAS float*)(lds + D_BIAS) + 128 * g, true, r32, hi);
        attn_store(o, l, YCAT + (grow + qpos) * YW + 768 + 64 * hq, hi);
    }
    __syncthreads();
}
constexpr int CW_OFF = 94 * 256 * 4;
__device__ __forceinline__ void conv_weights_to_lds(LAS unsigned char* lds, const float* wdw, int tid) {
    LAS float* w = (LAS float*)(lds + CW_OFF);
#pragma unroll
    for (int it = 0; it < 4; ++it) { const int idx = tid + 512 * it; if (idx < 31 * 64) *(LAS f32x4*)(w + 4 * idx) = *(const f32x4*)(wdw + 4 * idx); }
}
__device__ __forceinline__ void conv_unit(LAS unsigned char* lds, const bf16_t* PROJ, bf16_t* YCAT, const float* wshort, const float* dwb, const float* lng, const float* lnb, int bg, int bl, int tb, int tid, int wave, int lane) {
    const size_t prow = (size_t)bl * SEQ, grow = (size_t)bg * SEQ; const int t0 = 64 * tb;
    {
        const int grp = tid & 31;
        f32x4 w0[3], w1[3];
#pragma unroll
        for (int k = 0; k < 3; ++k) { w0[k] = *(const f32x4*)(wshort + k * 256 + 8 * grp); w1[k] = *(const f32x4*)(wshort + k * 256 + 8 * grp + 4); }
#pragma unroll 2
        for (int it = 0; it < 4; ++it) {
            const int tok = (tid >> 5) + 16 * it, t = t0 + tok;
            const bf16_t* src = PROJ + (prow + t) * NPROJ + 768 + 8 * grp;
            u32x4 c[3], x[3];
#pragma unroll
            for (int k = 0; k < 3; ++k) {
                const int tt = t - 2 + k;
                if (tt >= 0) { c[k] = *(const u32x4*)(src + (k - 2) * NPROJ + 256); x[k] = *(const u32x4*)(src + (k - 2) * NPROJ + 512); }
                else { c[k] = (u32x4){0u, 0u, 0u, 0u}; x[k] = (u32x4){0u, 0u, 0u, 0u}; }
            }
            const u32x4 b = *(const u32x4*)src;
            float acc[8];
#pragma unroll
            for (int e = 0; e < 8; ++e) acc[e] = 0.f;
#pragma unroll
            for (int k = 0; k < 3; ++k) {
                acc[0] += w0[k][0] * (bflo(c[k].x) * bflo(x[k].x)); acc[1] += w0[k][1] * (bfhi(c[k].x) * bfhi(x[k].x)); acc[2] += w0[k][2] * (bflo(c[k].y) * bflo(x[k].y)); acc[3] += w0[k][3] * (bfhi(c[k].y) * bfhi(x[k].y));
                acc[4] += w1[k][0] * (bflo(c[k].z) * bflo(x[k].z)); acc[5] += w1[k][1] * (bfhi(c[k].z) * bfhi(x[k].z)); acc[6] += w1[k][2] * (bflo(c[k].w) * bflo(x[k].w)); acc[7] += w1[k][3] * (bfhi(c[k].w) * bfhi(x[k].w));
            }
            u32x4 w; w.x = cvt_pk_bf16(bflo(b.x) * acc[0], bfhi(b.x) * acc[1]); w.y = cvt_pk_bf16(bflo(b.y) * acc[2], bfhi(b.y) * acc[3]); w.z = cvt_pk_bf16(bflo(b.z) * acc[4], bfhi(b.z) * acc[5]); w.w = cvt_pk_bf16(bflo(b.w) * acc[6], bfhi(b.w) * acc[7]);
            *(u32x4*)(YCAT + (grow + t) * YW + 256 + 8 * grp) = w;
        }
    }
    LAS float* glu = (LAS float*)lds;
#pragma unroll 3
    for (int it = 0; it < 6; ++it) {
        const int idx = tid + 512 * it;
        if (idx < 94 * 32) {
            const int r = idx >> 5, grp = idx & 31, tt = t0 - 30 + r;
            f32x4 g0 = {0.f, 0.f, 0.f, 0.f}, g1 = {0.f, 0.f, 0.f, 0.f};
            if (tt >= 0) {
                const bf16_t* src = PROJ + (prow + tt) * NPROJ + 1536 + 8 * grp;
                const u32x4 a = *(const u32x4*)src, s = *(const u32x4*)(src + 256);
                g0[0] = bflo(a.x) * sigmoid_f(bflo(s.x)); g0[1] = bfhi(a.x) * sigmoid_f(bfhi(s.x)); g0[2] = bflo(a.y) * sigmoid_f(bflo(s.y)); g0[3] = bfhi(a.y) * sigmoid_f(bfhi(s.y));
                g1[0] = bflo(a.z) * sigmoid_f(bflo(s.z)); g1[1] = bfhi(a.z) * sigmoid_f(bfhi(s.z)); g1[2] = bflo(a.w) * sigmoid_f(bflo(s.w)); g1[3] = bfhi(a.w) * sigmoid_f(bfhi(s.w));
            }
            *(LAS f32x4*)(glu + r * 256 + 8 * grp) = g0; *(LAS f32x4*)(glu + r * 256 + 8 * grp + 4) = g1;
        }
    }
    __syncthreads();
    {
        f32x4 acc[8];
#pragma unroll
        for (int i = 0; i < 8; ++i) acc[i] = (f32x4){0.f, 0.f, 0.f, 0.f};
        const LAS float* gb = glu + (8 * wave) * 256 + 4 * lane;
        const LAS float* wl = (const LAS float*)(lds + CW_OFF) + 4 * lane;
#pragma unroll 2
        for (int k = 0; k < 31; ++k) {
            const f32x4 wk = *(const LAS f32x4*)(wl + k * 256);
#pragma unroll
            for (int i = 0; i < 8; ++i) acc[i] = acc[i] + wk * *(const LAS f32x4*)(gb + (i + k) * 256);
        }
        const f32x4 bias = *(const f32x4*)(dwb + 4 * lane), gain = *(const f32x4*)(lng + 4 * lane), lb = *(const f32x4*)(lnb + 4 * lane);
#pragma unroll
        for (int i = 0; i < 8; ++i) {
            const f32x4 v = acc[i] + bias;
            const float mean = wave_sum((v[0] + v[1]) + (v[2] + v[3])) * (1.0f / 256.0f);
            const f32x4 d = v - mean;
            const float var = wave_sum((d[0] * d[0] + d[1] * d[1]) + (d[2] * d[2] + d[3] * d[3])) * (1.0f / 256.0f);
            const float rs = 1.0f / sqrtf(var + EPS);
            f32x4 y = (d * rs) * gain + lb;
#pragma unroll
            for (int e = 0; e < 4; ++e) y[e] = y[e] * sigmoid_f(y[e]);
            u32x2 w; w.x = cvt_pk_bf16(y[0], y[1]); w.y = cvt_pk_bf16(y[2], y[3]);
            *(u32x2*)(YCAT + (grow + t0 + 8 * wave + i) * YW + 512 + 4 * lane) = w;
        }
    }
    __syncthreads();
}
__device__ __forceinline__ void mixer_phase(const CAS Args* a, int L, int half, LAS unsigned char* lds, int bid, int tid, int wave, int lane) {
    const bf16_t* PROJ = (const bf16_t*)(a->ws + WS_PROJ); bf16_t* YCAT = (bf16_t*)(a->ws + WS_YCAT); const float* CUM = (const float*)(a->ws + WS_CUM);
    const int G = gridDim.x, B0 = 16 * half;
    for (int u = bid; u < 256; u += G) {
        const int bl = u >> 4, h = (u >> 2) & 3, pr = u & 3;
        attnA_unit(lds, PROJ, CUM, YCAT, B0 + bl, bl, h, 7 - pr, tid, wave, lane);
        attnA_unit(lds, PROJ, CUM, YCAT, B0 + bl, bl, h, pr, tid, wave, lane);
    }
    for (int u = bid; u < 512; u += G) {
        const int bl = u >> 5, kvh = (u >> 4) & 1, n = u & 15;
        attnD_unit(lds, PROJ, YCAT, a->in[16], a->in[15] + L * 8, a->bucket, B0 + bl, bl, kvh, n, tid, wave, lane);
    }
    conv_weights_to_lds(lds, a->in[11] + (size_t)L * 31 * 256, tid);
    for (int u = bid; u < 512; u += G) {
        const int bl = u >> 5, tb = u & 31;
        conv_unit(lds, PROJ, YCAT, a->in[10] + (size_t)L * 3 * 256, a->in[12] + L * 256, a->in[13] + L * 256, a->in[14] + L * 256, B0 + bl, bl, tb, tid, wave, lane);
    }
}

#define XB_TMO      128
#define XB_XCNT(j)  (256  + 64 * (j))
#define XB_XSUB(j)  (1280 + 64 * (j))
#define XB_XGEN(j)  (2304 + 64 * (j))
#define XB_TOP      3328
#define XB_TOPGEN   3392
#define XCD_BAR_WORDS 3456
#define XB_SPIN_CAP (1u << 22)

__device__ __forceinline__ unsigned xb_ld(unsigned* p)              { return __hip_atomic_load(p, __ATOMIC_RELAXED, __HIP_MEMORY_SCOPE_AGENT); }
__device__ __forceinline__ unsigned xb_add(unsigned* p, unsigned v) { return __hip_atomic_fetch_add(p, v, __ATOMIC_RELAXED, __HIP_MEMORY_SCOPE_AGENT); }
__device__ __forceinline__ unsigned xb_xcc_id() { return (unsigned)__builtin_amdgcn_s_getreg((3 << 11) | 20) & 0xFu; }
#define XB_SPIN(cond, bar) do { unsigned _sp = 0; while (cond) { __builtin_amdgcn_s_sleep(1); \
    if ((++_sp & 255u) == 0u) { if (xb_ld(&(bar)[XB_TMO])) break; if (_sp > XB_SPIN_CAP) { atomicAdd(&(bar)[XB_TMO], 1u); break; } } } } while (0)

struct XcdBarrier {
    unsigned* bar; unsigned x;
    volatile LAS unsigned* st;
};

__device__ __forceinline__ XcdBarrier xcd_barrier_post(unsigned* bar, volatile LAS unsigned* st) {
    XcdBarrier b; b.bar = bar; b.x = xb_xcc_id(); b.st = st;
    if (threadIdx.x == 0) (void)xb_add(&bar[XB_XCNT(b.x)], 1u);
    return b;
}
__device__ __forceinline__ void xcd_barrier_complete(unsigned* bar, unsigned x, unsigned& nloc, unsigned& nx) {
    const unsigned G = gridDim.x * gridDim.y * gridDim.z;
    unsigned sum, cnt, mine, sp = 0u;
    for (;;) {
        sum = 0u; cnt = 0u; mine = 0u;
#pragma unroll
        for (unsigned j = 0; j < 16; ++j) { const unsigned c = xb_ld(&bar[XB_XCNT(j)]); sum += c; cnt += (c > 0u) ? 1u : 0u; mine = (j == x) ? c : mine; }
        if (sum == G) break;
        __builtin_amdgcn_s_sleep(1);
        if ((++sp & 255u) == 0u) { if (xb_ld(&bar[XB_TMO])) break; if (sp > XB_SPIN_CAP) { atomicAdd(&bar[XB_TMO], 1u); break; } }
    }
    nloc = mine > 0u ? mine : 1u; nx = cnt > 0u ? cnt : 1u;
}

__device__ __forceinline__ void xcd_barrier(const XcdBarrier& b) {
    asm volatile("s_waitcnt vmcnt(0)" ::: "memory");
    __syncthreads();
    if (threadIdx.x == 0) {
        unsigned* bar = b.bar;
        __builtin_amdgcn_s_waitcnt(0);
        unsigned nloc = b.st[0], nx = b.st[1];
        if (nloc == 0u) { xcd_barrier_complete(bar, b.x, nloc, nx); b.st[0] = nloc; b.st[1] = nx; }
        const unsigned old = xb_add(&bar[XB_XSUB(b.x)], 1u);
        const unsigned gen = old / nloc;
        if (old + 1u == (gen + 1u) * nloc) {
            __builtin_amdgcn_fence(__ATOMIC_RELEASE, "agent");
            asm volatile("s_waitcnt vmcnt(0)" ::: "memory");
            const unsigned og = xb_add(&bar[XB_TOP], 1u);
            const unsigned tg = og / nx;
            if (og + 1u == (tg + 1u) * nx) xb_add(&bar[XB_TOPGEN], 1u);
            else XB_SPIN(xb_ld(&bar[XB_TOPGEN]) == tg, bar);
            __builtin_amdgcn_fence(__ATOMIC_ACQUIRE, "agent");
            xb_add(&bar[XB_XGEN(b.x)], 1u);
            asm volatile("s_waitcnt vmcnt(0)" ::: "memory");
        } else {
            XB_SPIN(xb_ld(&bar[XB_XGEN(b.x)]) == gen, bar);
            __builtin_amdgcn_fence(__ATOMIC_ACQUIRE, "agent");
            asm volatile("s_waitcnt vmcnt(0)" ::: "memory");
        }
    }
    __syncthreads();
}

__global__ void __launch_bounds__(NTHREADS, 2) mega(Args a_) {
    extern __shared__ __attribute__((aligned(16))) unsigned char lds_raw[];
    LAS unsigned char* lds = (LAS unsigned char*)lds_raw;
    const int ph_lo = a_.ph_lo, ph_hi = a_.ph_hi;
    { volatile LAS unsigned* bst = (volatile LAS unsigned*)(lds + 131072 + 64);
      if (threadIdx.x == 0) { bst[0] = 0u; bst[1] = 0u; }
      __syncthreads();
      (void)xcd_barrier_post((unsigned*)(a_.ws + WS_CTL_BAR), bst); }
    for (int ph = ph_lo; ph < ph_hi; ++ph) {
        const CAS Args* a = (const CAS Args*)__builtin_amdgcn_kernarg_segment_ptr();
        asm volatile("" : "+s"(a));
#define PH_IDS int tid = threadIdx.x; asm volatile("" : "+v"(tid)); const int lane = tid & 63, wave = __builtin_amdgcn_readfirstlane(tid >> 6); int bid = blockIdx.x; asm volatile("" : "+s"(bid)); const int G = gridDim.x, gw = bid * NWAVES + wave, NGW = G * NWAVES; (void)lane; (void)gw; (void)NGW; (void)G;
        unsigned char* ws = a->ws; float* OUT = a->out; unsigned short* H16 = (unsigned short*)(ws + WS_U);
        const int L = ph / PH_PER_LAYER, s = ph % PH_PER_LAYER;
        if (s == 0 && L > 0) continue;
        unsigned char* wsw = ws + ((L & 1) ? WS_WB - WS_W : 0);
        bf16_t* U = (bf16_t*)a->out; bf16_t* HID = (bf16_t*)(ws + WS_HID); bf16_t* F = (bf16_t*)(ws + WS_F); bf16_t* F2 = (bf16_t*)(ws + WS_F2);
        bf16_t* PROJ = (bf16_t*)(ws + WS_PROJ); bf16_t* YCAT = (bf16_t*)(ws + WS_YCAT); bf16_t* MERGED = (bf16_t*)(ws + WS_MERGED);
        float* LOGF = (float*)(ws + WS_LOGF); float* CUM = (float*)(ws + WS_CUM); bf16_t* PBF = (bf16_t*)(ws + WS_PBF);
        if (s == 0) { PH_IDS
            wconv_phase(a, L, -1, lds, gw, NGW, wave, lane);
            if (L == 0) { RowArgs R{a->in[0], nullptr, nullptr, nullptr, nullptr, nullptr, nullptr, 0.f, a->in[2], U, nullptr, nullptr, nullptr, nullptr, nullptr}; row_pass(R, gw, NGW, lane); }
            __syncthreads();
        } else if (s == 1 || s == 12) { PH_IDS
            pg8::Gemm g{U, (const bf16_t*)(wsw + (s == 1 ? W_GU1 : W_GU2)), M, 2 * FF, DM}; pg8::StaticOrder S; S.init(M, 2 * FF, G, bid);
            pg8::EpiSwiglu E{HID, FF};
            pg8::gemm_phase<pg8::EpiSwiglu, pg8::StaticOrder, true, true>(lds, g, S, E);
        } else if (s == 2 || s == 10 || s == 13 || s == 15) { PH_IDS
            const int nrep = (s == 15) ? 2 : 1;
            for (int rep = 0; rep < nrep; ++rep) {
                pg8::Gemm g; bf16_t* out;
                if (s == 2) { g = pg8::Gemm{HID, (const bf16_t*)(wsw + W_D1), M, DM, FF}; out = F; }
                else if (s == 13) { g = pg8::Gemm{HID, (const bf16_t*)(wsw + W_D2), M, DM, FF}; out = F; }
                else if (s == 10) { g = pg8::Gemm{MERGED, (const bf16_t*)(wsw + W_O), M, DM, DM}; out = F; }
                else if (rep == 0) { g = pg8::Gemm{U, (const bf16_t*)(wsw + W_PG), M, DM, DM}; out = F; }
                else { g = pg8::Gemm{PBF, (const bf16_t*)(wsw + W_PLE), M, DM, PLE}; out = F2; }
                pg8::StaticOrder S; S.init(M, DM, G, bid);
                pg8::EpiBf16 E{out, DM};
                pg8::gemm_phase<pg8::EpiBf16, pg8::StaticOrder, true, true>(lds, g, S, E);
            }
        } else if (s == 4 || s == 7) { PH_IDS
            const int half = (s == 7) ? 1 : 0;
            if (half == 0 && wave == 0) { for (int q = bid; q < NB * 4; q += G) cumsum_seq(LOGF, CUM, q, lane); }
            pg8::Gemm g{U + (size_t)half * MH * DM, (const bf16_t*)(wsw + W_IN), MH, NPROJ, DM}; pg8::StaticOrder S; S.init(MH, NPROJ, G, bid);
            pg8::EpiProj E{PROJ, NPROJ, a->in[9] + (size_t)L * 4096, QSCALE};
            pg8::gemm_phase<pg8::EpiProj, pg8::StaticOrder, true, true>(lds, g, S, E);
        } else if (s == 5 || s == 8) { PH_IDS
            mixer_phase(a, L, (s == 8) ? 1 : 0, lds, bid, tid, wave, lane);
            if (L + 1 < DEPTH) wconv_phase(a, L + 1, (s == 8) ? 1 : 0, lds, gw, NGW, wave, lane);
        } else if (s == 6 || s == 9) { PH_IDS
            const int half = (s == 9) ? 1 : 0;
            pg8::Gemm g{YCAT + (size_t)half * MH * YW, (const bf16_t*)(wsw + W_BR), MH, DM, YW}; pg8::StaticOrder S; S.init(MH, DM, G, bid);
            pg8::EpiMerge E{MERGED + (size_t)half * MH * DM, DM, PROJ + 2816, NPROJ};
            pg8::gemm_phase<pg8::EpiMerge, pg8::StaticOrder, true, true>(lds, g, S, E);
        } else { PH_IDS
            RowArgs R;
            const bool last = (L + 1 == DEPTH);
            if (s == 3)       R = RowArgs{L == 0 ? a->in[0] : nullptr, H16, nullptr, H16, F, nullptr, a->in[5] + L * DM, 0.5f, a->in[6] + L * DM, U, (const float*)(wsw + W_AF), a->in[8] + L * 4, LOGF, nullptr, nullptr};
            else if (s == 11) R = RowArgs{nullptr, H16, nullptr, H16, F, nullptr, a->in[22] + L * DM, 1.0f, a->in[23] + L * DM, U, nullptr, nullptr, nullptr, nullptr, nullptr};
            else if (s == 14) R = RowArgs{nullptr, H16, nullptr, H16, F, nullptr, a->in[26] + L * DM, 0.5f, a->in[27] + L * DM, U, nullptr, nullptr, nullptr, a->in[1] + (size_t)L * M * PLE, PBF};
            else              R = RowArgs{nullptr, H16, last ? OUT : nullptr, H16, F, F2, a->in[30] + L * DM, 1.0f, last ? nullptr : a->in[2] + (L + 1) * DM, U, nullptr, nullptr, nullptr, nullptr, nullptr};
            row_pass(R, gw, NGW, lane);
        }
        if (ph + 1 < ph_hi) { if (ph == ph_lo) cg::this_grid().sync(); else { XcdBarrier xbar; xbar.bar = (unsigned*)(a->ws + WS_CTL_BAR); xbar.x = xb_xcc_id(); xbar.st = (volatile LAS unsigned*)(lds + 131072 + 64); xcd_barrier(xbar); } }
    }
}

extern "C" void kernel_launch(void* const* d_in, const int* in_sizes, int n_in, void* d_out, int out_size, void* d_ws, size_t ws_size, hipStream_t stream) {
    static int grid = 0;
    if (grid == 0) {
        if (n_in != 31 || out_size != M * DM || ws_size < WS_NEED) { fprintf(stderr, "kernel_launch: unexpected shapes (n_in %d, out %d, ws %zu)\n", n_in, out_size, ws_size); grid = -1; return; }
        int dev = 0, cus = 0, per_cu = 0;
        if (hipGetDevice(&dev) != hipSuccess || hipDeviceGetAttribute(&cus, hipDeviceAttributeMultiprocessorCount, dev) != hipSuccess) { grid = -1; return; }
        if (hipFuncSetAttribute((const void*)mega, hipFuncAttributeMaxDynamicSharedMemorySize, LDS_BYTES) != hipSuccess) { fprintf(stderr, "kernel_launch: hipFuncSetAttribute failed\n"); grid = -1; return; }
        if (hipOccupancyMaxActiveBlocksPerMultiprocessor(&per_cu, (const void*)mega, NTHREADS, LDS_BYTES) != hipSuccess || per_cu < 1) { fprintf(stderr, "kernel_launch: occupancy query says %d\n", per_cu); per_cu = 1; }
        (void)hipGetLastError();
        grid = cus * per_cu;
        fprintf(stderr, "kernel_launch: grid %d (cus %d x %d)\n", grid, cus, per_cu);
    }
    if (grid < 0) return;
    Args a{};
    for (int i = 0; i < 31; ++i) a.in[i] = (const float*)d_in[i];
    a.out = (float*)d_out; a.ws = (unsigned char*)d_ws;
    for (int d = 0; d < 128; ++d) {
        int bkt;
        if (d < 16) bkt = d;
        else { const float v = logf((float)d / 16.0f) / (float)log(128.0 / 16.0) * 16.0f; bkt = 16 + (int)v; if (bkt > 31) bkt = 31; }
        a.bucket[d] = (unsigned char)bkt;
    }
#if MK_ONE_LAUNCH
    if (hipMemsetAsync(d_ws, 0, CTL_ZERO_BYTES, stream) != hipSuccess) { fprintf(stderr, "kernel_launch: memset failed\n"); return; }
    a.ph_lo = 0; a.ph_hi = N_PHASES;
    void* args[] = {&a};
    hipError_t e = hipLaunchCooperativeKernel((const void*)mega, dim3(grid), dim3(NTHREADS), args, LDS_BYTES, stream);
    if (e != hipSuccess) fprintf(stderr, "kernel_launch: cooperative launch failed: %s (grid %d)\n", hipGetErrorString(e), grid);
#else
    for (int ph = 0; ph < N_PHASES; ++ph) {
        a.ph_lo = ph; a.ph_hi = ph + 1;
        hipLaunchKernelGGL(mega, dim3(grid), dim3(NTHREADS), LDS_BYTES, stream, a);
    }
#endif
}
```

```cpp
#include <hip/hip_runtime.h>
#include <hip/hip_cooperative_groups.h>
#include <cstdio>
#include <cstdint>
#include <cmath>
namespace cg = cooperative_groups;

#ifndef MK_ONE_LAUNCH
#define MK_ONE_LAUNCH 1
#endif
namespace pg8 {
#define PG8_LAS __attribute__((address_space(3)))
typedef unsigned short bf16_t;
typedef short bf16x8 __attribute__((ext_vector_type(8)));
typedef float f32x4 __attribute__((ext_vector_type(4)));
typedef unsigned u32x4 __attribute__((ext_vector_type(4)));
typedef unsigned u32x2 __attribute__((ext_vector_type(2)));
constexpr int BM = 256, BK = 64, HALF = 128, HTB = HALF * BK * 2  , STAGE_BYTES = 8 * HTB, NXCD = 8, WGM = 8;

__host__ __device__ __forceinline__ int lds_byte(int r, int c) { const int st = (r >> 4) * 2 + (c >> 5), rr = r & 15, cc = c & 31, ob = rr * 64 + cc * 2; return st * 1024 + (ob ^ (((ob >> 9) & 1) << 5)); }
__host__ __device__ __forceinline__ void stage_rc(int b, int& R, int& C) { const int st = b / 1024, sb = b % 1024, swz = sb ^ (((sb >> 9) & 1) << 5); R = (st >> 1) * 16 + swz / 64; C = (st & 1) * 32 + (swz % 64) / 2; }
__host__ __device__ __forceinline__ int perm32(int rho) { const int n = rho >> 4, i = rho & 15; return 8 * (i >> 2) + 4 * n + (i & 3); }

struct Unit { int pm, pn; };
struct Gemm { const bf16_t* A; const bf16_t* Bt; int M, N, K; };

struct StaticOrder {
    int nM, nN, nwg, G, c;
    __host__ __device__ void init(int M, int N, int G_, int c_) { nM = M / BM; nN = N / BM; nwg = nM * nN; G = G_; c = c_; }
    __host__ __device__ bool next(int i, Unit& u) const {
        const long L = (long)i * G + c; if (L >= nwg) return false;
        int wgid = (int)L; { const int q = nwg / NXCD, r = nwg % NXCD, xcd = wgid % NXCD, off = wgid / NXCD; wgid = (xcd < r ? xcd * (q + 1) : r * (q + 1) + (xcd - r) * q) + off; }
        const int nig = WGM * nN, gid = wgid / nig, fm = gid * WGM, gsz = (nM - fm) < WGM ? (nM - fm) : WGM;
        u.pm = fm + ((wgid % nig) % gsz); u.pn = (wgid % nig) / gsz; return true;
    }
    __device__ __forceinline__ void a_ready(const Unit&) const {}
    __device__ __forceinline__ void done(const Unit&) const {}
};

__device__ __forceinline__ unsigned cvt_pk_bf16(float lo, float hi) { unsigned r; asm volatile("v_cvt_pk_bf16_f32 %0, %1, %2" : "=v"(r) : "v"(lo), "v"(hi)); return r; }
typedef float f32x2 __attribute__((ext_vector_type(2)));

__device__ __forceinline__ float bf2f(unsigned short v) { return __uint_as_float(((unsigned)v) << 16); }
__device__ __forceinline__ float bflo(unsigned w) { return __uint_as_float(w << 16); }
__device__ __forceinline__ float bfhi(unsigned w) { return __uint_as_float(w & 0xffff0000u); }
__device__ __forceinline__ float sigmoid_f(float x) { return __builtin_amdgcn_rcpf(1.0f + __builtin_amdgcn_exp2f(-1.4426950408889634f * x)); }

struct EpiSwiglu {
    static constexpr bool PERM = true, AFTER_DRAIN = false, HOOK = false;
    bf16_t* O; int ldc;
    __device__ __forceinline__ void operator()(const f32x4 (&acc)[2][2][4][2], const Unit& u, int wr, int wc, int fr, int fq) const {
        const int row0 = u.pm * BM + wr * 64 + fr, col0 = u.pn * HALF + wc * 32 + 8 * fq;
#pragma unroll
        for (int ai = 0; ai < 2; ++ai)
#pragma unroll
            for (int m = 0; m < 4; ++m) {
                bf16_t* rowp = O + (size_t)(row0 + ai * HALF + m * 16) * ldc + col0;
                float v[8];
#pragma unroll
                for (int n = 0; n < 2; ++n)
#pragma unroll
                    for (int e = 0; e < 4; ++e) { const float g = acc[ai][0][m][n][e], up = acc[ai][1][m][n][e]; v[4 * n + e] = g * sigmoid_f(g) * up; }
                u32x4 w; w.x = cvt_pk_bf16(v[0], v[1]); w.y = cvt_pk_bf16(v[2], v[3]); w.z = cvt_pk_bf16(v[4], v[5]); w.w = cvt_pk_bf16(v[6], v[7]);
                *(u32x4*)rowp = w;
            }
    }
};
struct EpiF32 {
    static constexpr bool PERM = false, AFTER_DRAIN = false, HOOK = false;
    float* O; int ldc;
    __device__ __forceinline__ void operator()(const f32x4 (&acc)[2][2][4][2], const Unit& u, int wr, int wc, int fr, int fq) const {
        const int row0 = u.pm * BM + wr * 64 + fr, col0 = u.pn * BM + wc * 32 + 4 * fq;
#pragma unroll
        for (int ai = 0; ai < 2; ++ai)
#pragma unroll
            for (int m = 0; m < 4; ++m) {
                float* rowp = O + (size_t)(row0 + ai * HALF + m * 16) * ldc + col0;
#pragma unroll
                for (int bj = 0; bj < 2; ++bj)
#pragma unroll
                    for (int n = 0; n < 2; ++n) *(f32x4*)(rowp + bj * HALF + n * 16) = acc[ai][bj][m][n];
            }
    }
};
struct EpiBf16 {
    static constexpr bool PERM = true, AFTER_DRAIN = false, HOOK = false;
    bf16_t* O; int ldc;
    __device__ __forceinline__ void operator()(const f32x4 (&acc)[2][2][4][2], const Unit& u, int wr, int wc, int fr, int fq) const {
        const int row0 = u.pm * BM + wr * 64 + fr, col0 = u.pn * BM + wc * 32 + 8 * fq;
#pragma unroll
        for (int ai = 0; ai < 2; ++ai)
#pragma unroll
            for (int m = 0; m < 4; ++m) {
                bf16_t* rowp = O + (size_t)(row0 + ai * HALF + m * 16) * ldc + col0;
#pragma unroll
                for (int bj = 0; bj < 2; ++bj) {
                    const f32x4 v0 = acc[ai][bj][m][0], v1 = acc[ai][bj][m][1];
                    u32x4 w; w.x = cvt_pk_bf16(v0[0], v0[1]); w.y = cvt_pk_bf16(v0[2], v0[3]); w.z = cvt_pk_bf16(v1[0], v1[1]); w.w = cvt_pk_bf16(v1[2], v1[3]);
                    *(u32x4*)(rowp + bj * HALF) = w;
                }
            }
    }
};
struct EpiProj {
    static constexpr bool PERM = true, AFTER_DRAIN = false, HOOK = false;
    bf16_t* O; int ldc; const float* bgate; float qscale;
    __device__ __forceinline__ void operator()(const f32x4 (&acc)[2][2][4][2], const Unit& u, int wr, int wc, int fr, int fq) const {
        const int row0 = u.pm * BM + wr * 64 + fr;
        if (u.pn >= 11) {
            const int oc = 64 * (u.pn - 11) + 16 * wc + 4 * fq;
            f32x4 bv[4];
#pragma unroll
            for (int k = 0; k < 4; ++k) bv[k] = *(const f32x4*)(bgate + 1024 * k + oc);
#pragma unroll
            for (int ai = 0; ai < 2; ++ai)
#pragma unroll
                for (int m = 0; m < 4; ++m) {
                    bf16_t* rowp = O + (size_t)(row0 + ai * HALF + m * 16) * ldc + 2816 + oc;
                    f32x4 g0 = acc[ai][0][m][0] + bv[0], g1 = acc[ai][0][m][1] + bv[1], g2 = acc[ai][1][m][0] + bv[2], g3 = acc[ai][1][m][1] + bv[3], r1, r2, r3;
#pragma unroll
                    for (int e = 0; e < 4; ++e) {
                        g0[e] = fmaxf(sigmoid_f(g0[e]), 1e-6f); g1[e] = fmaxf(sigmoid_f(g1[e]), 1e-6f); g2[e] = fmaxf(sigmoid_f(g2[e]), 1e-6f); g3[e] = fmaxf(sigmoid_f(g3[e]), 1e-6f);
                        r1[e] = g0[e] * __builtin_amdgcn_rcpf(g1[e]); r2[e] = g1[e] * __builtin_amdgcn_rcpf(g2[e]); r3[e] = g2[e] * __builtin_amdgcn_rcpf(g3[e]);
                    }
                    u32x2 w;
                    w.x = cvt_pk_bf16(r1[0], r1[1]); w.y = cvt_pk_bf16(r1[2], r1[3]); *(u32x2*)(rowp) = w;
                    w.x = cvt_pk_bf16(r2[0], r2[1]); w.y = cvt_pk_bf16(r2[2], r2[3]); *(u32x2*)(rowp + 1024) = w;
                    w.x = cvt_pk_bf16(r3[0], r3[1]); w.y = cvt_pk_bf16(r3[2], r3[3]); *(u32x2*)(rowp + 2048) = w;
                    w.x = cvt_pk_bf16(g3[0], g3[1]); w.y = cvt_pk_bf16(g3[2], g3[3]); *(u32x2*)(rowp + 3072) = w;
                }
        } else {
            const int col0 = u.pn * BM + wc * 32 + 8 * fq;
            const float sc = (u.pn == 0 || u.pn == 8 || u.pn == 9) ? qscale : 1.0f;
#pragma unroll
            for (int ai = 0; ai < 2; ++ai)
#pragma unroll
                for (int m = 0; m < 4; ++m) {
                    bf16_t* rowp = O + (size_t)(row0 + ai * HALF + m * 16) * ldc + col0;
#pragma unroll
                    for (int bj = 0; bj < 2; ++bj) {
                        const f32x4 v0 = acc[ai][bj][m][0] * sc, v1 = acc[ai][bj][m][1] * sc;
                        u32x4 w; w.x = cvt_pk_bf16(v0[0], v0[1]); w.y = cvt_pk_bf16(v0[2], v0[3]); w.z = cvt_pk_bf16(v1[0], v1[1]); w.w = cvt_pk_bf16(v1[2], v1[3]);
                        *(u32x4*)(rowp + bj * HALF) = w;
                    }
                }
        }
    }
};
struct EpiMerge {
    static constexpr bool PERM = true, AFTER_DRAIN = false, HOOK = true;
    bf16_t* O; int ldc; const bf16_t* G; int ldg;
    __device__ __forceinline__ void hook(f32x4 (&acc)[2][2][4][2], const Unit& u, int br, int wr, int wc, int fr, int fq) const {
        const int row0 = u.pm * BM + wr * 64 + fr, col0 = u.pn * BM + wc * 32 + 8 * fq;
        u32x4 rr[2][4][2];
#pragma unroll
        for (int ai = 0; ai < 2; ++ai)
#pragma unroll
            for (int m = 0; m < 4; ++m) {
                const bf16_t* gp = G + (size_t)(row0 + ai * HALF + m * 16) * ldg + col0 + 1024 * (br - 1);
#pragma unroll
                for (int bj = 0; bj < 2; ++bj) rr[ai][m][bj] = __builtin_nontemporal_load((const u32x4*)(gp + bj * HALF));
            }
#pragma unroll
        for (int ai = 0; ai < 2; ++ai)
#pragma unroll
            for (int m = 0; m < 4; ++m)
#pragma unroll
                for (int bj = 0; bj < 2; ++bj) {
                    const u32x4 q = rr[ai][m][bj];
                    acc[ai][bj][m][0] = acc[ai][bj][m][0] * (f32x4){bflo(q.x), bfhi(q.x), bflo(q.y), bfhi(q.y)};
                    acc[ai][bj][m][1] = acc[ai][bj][m][1] * (f32x4){bflo(q.z), bfhi(q.z), bflo(q.w), bfhi(q.w)};
                }
        asm volatile("" ::: "memory");
    }
    __device__ __forceinline__ void operator()(const f32x4 (&acc)[2][2][4][2], const Unit& u, int wr, int wc, int fr, int fq) const {
        const int row0 = u.pm * BM + wr * 64 + fr, col0 = u.pn * BM + wc * 32 + 8 * fq;
#pragma unroll
        for (int ai = 0; ai < 2; ++ai) {
            u32x4 gc[4][2];
#pragma unroll
            for (int m = 0; m < 4; ++m)
#pragma unroll
                for (int bj = 0; bj < 2; ++bj) gc[m][bj] = *(const u32x4*)(G + (size_t)(row0 + ai * HALF + m * 16) * ldg + col0 + 3072 + bj * HALF);
#pragma unroll
            for (int m = 0; m < 4; ++m) {
                bf16_t* rowp = O + (size_t)(row0 + ai * HALF + m * 16) * ldc + col0;
#pragma unroll
                for (int bj = 0; bj < 2; ++bj) {
                    const u32x4 c = gc[m][bj];
                    const f32x4 a0 = acc[ai][bj][m][0], a1 = acc[ai][bj][m][1];
                    u32x4 w; w.x = cvt_pk_bf16(a0[0] * bflo(c.x), a0[1] * bfhi(c.x)); w.y = cvt_pk_bf16(a0[2] * bflo(c.y), a0[3] * bfhi(c.y));
                    w.z = cvt_pk_bf16(a1[0] * bflo(c.z), a1[1] * bfhi(c.z)); w.w = cvt_pk_bf16(a1[2] * bflo(c.w), a1[3] * bfhi(c.w));
                    *(u32x4*)(rowp + bj * HALF) = w;
                }
            }
            asm volatile("" ::: "memory");
        }
    }
};
template <class Epi, class Sched, bool ALIGN_EPI = false, bool SP2 = false>
__device__ __forceinline__ void gemm_phase(PG8_LAS unsigned char* lds, const Gemm g, const Sched& S, const Epi& E) {
    int tid_ = threadIdx.x; asm volatile("" : "+v"(tid_));
    const int tid = tid_, wid = __builtin_amdgcn_readfirstlane(tid >> 6), lane = tid & 63, wr = wid >> 2, wc = wid & 3, fr = lane & 15, fq = lane >> 4;
    const int K = g.K, nt = K / BK;
    unsigned voffA[2], voffB[2];
#pragma unroll
    for (int i = 0; i < 2; ++i) { int R, C; stage_rc(tid * 16 + i * 8192, R, C); const int Rb = Epi::PERM ? ((R & ~31) + perm32(R & 31)) : R;
        voffA[i] = (unsigned)(R * K + C) * 2u; voffB[i] = (unsigned)(Rb * K + C) * 2u; }
    const size_t kstep = (size_t)(BK * 2);
    const size_t hstep = (size_t)HALF * K * 2;
    const size_t tstep = 2 * hstep;
    const unsigned ldsw = (unsigned)wid * 1024u;
    const int aoff = lds_byte(wr * 64 + fr, fq * 8), boff = lds_byte(wc * 32 + fr, fq * 8);
#define PG8_SA(b, h) (((b) * 2 + (h)) * HTB)
#define PG8_SB(b, h) ((4 + (b) * 2 + (h)) * HTB)
#define PG8_STAGE(bufoff, gbase, voff) do { _Pragma("unroll") for (int _i = 0; _i < 2; ++_i) \
        __builtin_amdgcn_global_load_lds((const unsigned*)((const char*)(gbase) + (voff)[_i]), (PG8_LAS unsigned*)(lds + (bufoff) + ldsw + _i * 8192), 16, 0, 0); } while (0)
#define PG8_LDA(dst, b, h) do { _Pragma("unroll") for (int m = 0; m < 4; ++m) _Pragma("unroll") for (int k = 0; k < 2; ++k) dst[m][k] = *(const PG8_LAS bf16x8*)(lds + PG8_SA(b, h) + aoff + m * 2048 + k * 1024); } while (0)
#define PG8_LDB(dst, b, h) do { _Pragma("unroll") for (int n = 0; n < 2; ++n) _Pragma("unroll") for (int k = 0; k < 2; ++k) dst[n][k] = *(const PG8_LAS bf16x8*)(lds + PG8_SB(b, h) + boff + n * 2048 + k * 1024); } while (0)
#define PG8_MMA(ai, bj, At, Bt) do { __builtin_amdgcn_s_setprio(1); _Pragma("unroll") for (int m = 0; m < 4; ++m) _Pragma("unroll") for (int n = 0; n < 2; ++n) _Pragma("unroll") for (int k = 0; k < 2; ++k) \
        acc[ai][bj][m][n] = __builtin_amdgcn_mfma_f32_16x16x32_bf16(Bt[n][k], At[m][k], acc[ai][bj][m][n], 0, 0, 0); __builtin_amdgcn_s_setprio(0); } while (0)
#define PG8_WAIT_V(n) asm volatile("s_waitcnt vmcnt(" #n ")" ::: "memory")
#define PG8_WAIT_L(n) asm volatile("s_waitcnt lgkmcnt(" #n ")" ::: "memory")
#define PG8_BAR __builtin_amdgcn_s_barrier()
#define PG8_SCHED __builtin_amdgcn_sched_barrier(0)
    Unit cur, nxt; int ui = 0;
    if (!S.next(0, cur)) return;
    f32x4 acc[2][2][4][2];
#pragma unroll
    for (int a = 0; a < 2; ++a)
#pragma unroll
        for (int b = 0; b < 2; ++b)
#pragma unroll
            for (int m = 0; m < 4; ++m)
#pragma unroll
                for (int n = 0; n < 2; ++n) acc[a][b][m][n] = (f32x4){0.f, 0.f, 0.f, 0.f};
    bf16x8 At[4][2], B0[2][2], B1[2][2];
    const char* cA = (const char*)g.A + (size_t)cur.pm * tstep; const char* cB = (const char*)g.Bt + (size_t)cur.pn * tstep;
    S.a_ready(cur);
    if constexpr (SP2) {
        PG8_STAGE(PG8_SB(0, 0), cB, voffB); PG8_STAGE(PG8_SB(0, 1), cB + hstep, voffB); PG8_STAGE(PG8_SA(0, 0), cA, voffA); PG8_STAGE(PG8_SA(0, 1), cA + hstep, voffA);
        if (wr == 1) PG8_BAR;
        PG8_WAIT_V(2); PG8_BAR;
        PG8_STAGE(PG8_SB(1, 0), cB + kstep, voffB); PG8_STAGE(PG8_SA(1, 0), cA + kstep, voffA); PG8_STAGE(PG8_SB(1, 1), cB + hstep + kstep, voffB);
        PG8_WAIT_V(6); PG8_BAR;
    } else {
        PG8_STAGE(PG8_SB(0, 0), cB, voffB); PG8_STAGE(PG8_SA(0, 0), cA, voffA); PG8_STAGE(PG8_SB(0, 1), cB + hstep, voffB); PG8_STAGE(PG8_SA(0, 1), cA + hstep, voffA);
        if (wr == 1) PG8_BAR;
        PG8_WAIT_V(4); PG8_BAR;
        PG8_STAGE(PG8_SB(1, 0), cB + kstep, voffB); PG8_STAGE(PG8_SA(1, 0), cA + kstep, voffA); PG8_STAGE(PG8_SB(1, 1), cB + hstep + kstep, voffB);
        PG8_WAIT_V(6); PG8_BAR;
    }
    for (;;) {
        const bool has_next = S.next(ui + 1, nxt);
        const char* nA = has_next ? (const char*)g.A + (size_t)nxt.pm * tstep : cA; const char* nB = has_next ? (const char*)g.Bt + (size_t)nxt.pn * tstep : cB;
        for (int t = 0; t < nt; t += 2) {
            if constexpr (Epi::HOOK) { if (t == 4 || t == 8 || t == 12) E.hook(acc, cur, t >> 2, wr, wc, fr, fq); }
            const bool last = (t == nt - 2);
            const char* a1 = cA + (size_t)(t + 1) * kstep;
            const char* a2 = last ? nA : cA + (size_t)(t + 2) * kstep; const char* b2 = last ? nB : cB + (size_t)(t + 2) * kstep;
            const char* a3 = a2 + kstep; const char* b3 = b2 + kstep;
            if (last && has_next) S.a_ready(nxt);
            if constexpr (SP2) {
            PG8_LDB(B0, 0, 0); PG8_LDB(B1, 0, 1); PG8_SCHED; PG8_LDA(At, 0, 0); PG8_STAGE(PG8_SA(1, 1), a1 + hstep, voffA);
            PG8_WAIT_V(8); PG8_WAIT_L(0); PG8_BAR; PG8_MMA(0, 0, At, B0); PG8_MMA(0, 1, At, B1); PG8_BAR; PG8_SCHED;
            PG8_LDA(At, 0, 1); PG8_STAGE(PG8_SB(0, 0), b2, voffB); PG8_STAGE(PG8_SB(0, 1), b2 + hstep, voffB); PG8_STAGE(PG8_SA(0, 0), a2, voffA);
            PG8_WAIT_V(8); PG8_WAIT_L(0); PG8_BAR; PG8_MMA(1, 0, At, B0); PG8_MMA(1, 1, At, B1); PG8_BAR; PG8_SCHED;
            PG8_LDB(B0, 1, 0); PG8_LDB(B1, 1, 1); PG8_SCHED; PG8_LDA(At, 1, 0); PG8_STAGE(PG8_SA(0, 1), a2 + hstep, voffA);
            PG8_WAIT_V(8); PG8_WAIT_L(0); PG8_BAR; PG8_MMA(0, 0, At, B0); PG8_MMA(0, 1, At, B1); PG8_BAR; PG8_SCHED;
            PG8_LDA(At, 1, 1); PG8_STAGE(PG8_SB(1, 0), b3, voffB); PG8_STAGE(PG8_SB(1, 1), b3 + hstep, voffB); PG8_STAGE(PG8_SA(1, 0), a3, voffA);
            PG8_WAIT_V(8); PG8_WAIT_L(0); PG8_BAR; PG8_MMA(1, 0, At, B0); PG8_MMA(1, 1, At, B1); PG8_BAR; PG8_SCHED;
            } else {
            PG8_LDB(B0, 0, 0); PG8_SCHED; PG8_LDA(At, 0, 0); PG8_STAGE(PG8_SA(1, 1), a1 + hstep, voffA);
            PG8_WAIT_L(8); PG8_BAR; PG8_WAIT_L(0); PG8_MMA(0, 0, At, B0); PG8_BAR; PG8_SCHED;
            PG8_LDB(B1, 0, 1); PG8_STAGE(PG8_SB(0, 0), b2, voffB);
            PG8_BAR; PG8_WAIT_L(0); PG8_MMA(0, 1, At, B1); PG8_BAR;
            PG8_LDA(At, 0, 1); PG8_STAGE(PG8_SA(0, 0), a2, voffA);
            PG8_BAR; PG8_WAIT_L(0); PG8_MMA(1, 0, At, B0); PG8_BAR; PG8_SCHED;
            PG8_STAGE(PG8_SB(0, 1), b2 + hstep, voffB);
            PG8_WAIT_V(6); PG8_BAR; PG8_MMA(1, 1, At, B1); PG8_BAR;
            PG8_LDB(B0, 1, 0); PG8_SCHED; PG8_LDA(At, 1, 0); PG8_STAGE(PG8_SA(0, 1), a2 + hstep, voffA);
            PG8_WAIT_L(8); PG8_BAR; PG8_WAIT_L(0); PG8_MMA(0, 0, At, B0); PG8_BAR; PG8_SCHED;
            PG8_LDB(B1, 1, 1); PG8_STAGE(PG8_SB(1, 0), b3, voffB);
            PG8_BAR; PG8_WAIT_L(0); PG8_MMA(0, 1, At, B1); PG8_BAR;
            PG8_LDA(At, 1, 1); PG8_STAGE(PG8_SA(1, 0), a3, voffA);
            PG8_BAR; PG8_WAIT_L(0); PG8_MMA(1, 0, At, B0); PG8_BAR; PG8_SCHED;
            PG8_STAGE(PG8_SB(1, 1), b3 + hstep, voffB);
            PG8_WAIT_V(6); PG8_BAR; PG8_MMA(1, 1, At, B1); PG8_BAR;
            }
        }
        if constexpr (ALIGN_EPI) { if (wr == 0) PG8_BAR; }
        if constexpr (!Epi::AFTER_DRAIN) { E(acc, cur, wr, wc, fr, fq); S.done(cur); }
        if (!has_next) break;
#pragma unroll
        for (int a = 0; a < 2; ++a)
#pragma unroll
            for (int b = 0; b < 2; ++b)
#pragma unroll
                for (int m = 0; m < 4; ++m)
#pragma unroll
                    for (int n = 0; n < 2; ++n) acc[a][b][m][n] = (f32x4){0.f, 0.f, 0.f, 0.f};
        cur = nxt; cA = nA; cB = nB; ++ui;
        if constexpr (ALIGN_EPI) { if (wr == 1) PG8_BAR; }
    }
    PG8_WAIT_V(0);
    if constexpr (!ALIGN_EPI) { if (wr == 0) PG8_BAR; }
    PG8_BAR;
    if constexpr (Epi::AFTER_DRAIN) { E.fused(acc, cur, wr, wc, fr, fq, lds, wid, lane); S.done(cur); }
#undef PG8_SA
#undef PG8_SB
#undef PG8_STAGE
#undef PG8_LDA
#undef PG8_LDB
#undef PG8_MMA
#undef PG8_WAIT_V
#undef PG8_WAIT_L
#undef PG8_BAR
#undef PG8_SCHED
}
}

#define LAS __attribute__((address_space(3)))
typedef unsigned short bf16_t;
typedef short bf16x8 __attribute__((ext_vector_type(8)));
typedef float f32x4 __attribute__((ext_vector_type(4)));
typedef float f32x16 __attribute__((ext_vector_type(16)));
typedef unsigned u32x4 __attribute__((ext_vector_type(4)));
typedef unsigned u32x2 __attribute__((ext_vector_type(2)));
using pg8::bflo; using pg8::bfhi; using pg8::sigmoid_f; using pg8::cvt_pk_bf16;

constexpr int DM = 1024, NB = 32, SEQ = 2048, DEPTH = 4, M = NB * SEQ, FF = 2816, NIN = 6916, NPROJ = 6912, PLE = 256, YW = 1280;
constexpr int MH = M / 2;
constexpr float EPS = 1e-6f, LOG2E = 1.4426950408889634f, QSCALE = 0.125f * 1.4426950408889634f, NEGBIG = -1e30f;
constexpr int NWAVES = 8, NTHREADS = 512;
constexpr int LDS_BYTES = 147456;
constexpr int PH_PER_LAYER = 17, N_PHASES = PH_PER_LAYER * DEPTH;

constexpr size_t MiB = 1u << 20;
constexpr size_t WS_W = 1 * MiB, WS_CTL_BAR = 16384, CTL_ZERO_BYTES = 65536;
constexpr size_t W_GU1 = WS_W, W_D1 = W_GU1 + (size_t)2 * FF * DM * 2, W_IN = W_D1 + (size_t)DM * FF * 2, W_BR = W_IN + (size_t)NPROJ * DM * 2, W_O = W_BR + (size_t)DM * YW * 2,
                 W_GU2 = W_O + (size_t)DM * DM * 2, W_D2 = W_GU2 + (size_t)2 * FF * DM * 2, W_PG = W_D2 + (size_t)DM * FF * 2, W_PLE = W_PG + (size_t)DM * DM * 2, W_AF = W_PLE + (size_t)DM * PLE * 2, W_END = W_AF + 16384;
static_assert(W_END <= 58 * MiB, "weights region");
constexpr size_t WS_U = 64 * MiB, WS_HID = 192 * MiB, WS_F = 544 * MiB, WS_PROJ = 192 * MiB, WS_YCAT = 624 * MiB, WS_MERGED = 800 * MiB, WS_LOGF = 928 * MiB, WS_CUM = 929 * MiB, WS_PBF = 930 * MiB, WS_F2 = 192 * MiB, WS_WB = 962 * MiB, WS_NEED = 1020 * MiB;
static_assert(WS_PROJ + (size_t)MH * NPROJ * 2 <= WS_YCAT && WS_YCAT + (size_t)M * YW * 2 <= WS_MERGED && WS_MERGED + (size_t)M * DM * 2 <= WS_LOGF && WS_HID + (size_t)M * FF * 2 <= WS_F && WS_F + (size_t)M * DM * 4 <= WS_MERGED && WS_PBF + (size_t)M * PLE * 2 <= WS_NEED && WS_F2 + (size_t)M * DM * 4 <= WS_F, "ws map");

#define CAS __attribute__((address_space(4)))
struct Args { const float* in[31]; float* out; unsigned char* ws; int ph_lo, ph_hi; unsigned char bucket[128]; };

template <int CTRL> __device__ __forceinline__ float dpp_f(float v) { return __builtin_bit_cast(float, __builtin_amdgcn_update_dpp(0, __builtin_bit_cast(int, v), CTRL, 0xf, 0xf, false)); }
__device__ __forceinline__ float wave_sum(float v) {
    v += dpp_f<0xB1>(v);
    v += dpp_f<0x4E>(v);
    v += dpp_f<0x141>(v);
    v += dpp_f<0x140>(v);
    const int b = __builtin_bit_cast(int, v);
    const float r0 = __builtin_bit_cast(float, __builtin_amdgcn_readlane(b, 0)), r1 = __builtin_bit_cast(float, __builtin_amdgcn_readlane(b, 16));
    const float r2 = __builtin_bit_cast(float, __builtin_amdgcn_readlane(b, 32)), r3 = __builtin_bit_cast(float, __builtin_amdgcn_readlane(b, 48));
    return (r0 + r1) + (r2 + r3);
}
__device__ __forceinline__ unsigned f2bf(float f) { unsigned u = __builtin_bit_cast(unsigned, f); return (u + 0x7fffu + ((u >> 16) & 1u)) >> 16; }
__device__ __forceinline__ unsigned pk2(float lo, float hi) { return f2bf(lo) | (f2bf(hi) << 16); }

__device__ __forceinline__ void transpose_item(const float* W, int ldn, int k0, int srccol  , bf16_t* WT, int ldk, int dst_row0, int dst_k0, LAS float* scr, int lane) {
#pragma unroll 8
    for (int i = 0; i < 32; ++i) { const int kk = 2 * i + (lane >> 5); scr[kk * 33 + (lane & 31)] = W[(size_t)(k0 + kk) * ldn + srccol]; }
    asm volatile("s_waitcnt lgkmcnt(0)" ::: "memory");
    const int c = lane & 7;
#pragma unroll
    for (int j = 0; j < 4; ++j) { const int n = (lane >> 3) + 8 * j; const LAS float* s = scr + (8 * c) * 33 + n;
        u32x4 o; o.x = pk2(s[0 * 33], s[1 * 33]); o.y = pk2(s[2 * 33], s[3 * 33]); o.z = pk2(s[4 * 33], s[5 * 33]); o.w = pk2(s[6 * 33], s[7 * 33]);
        *(u32x4*)(WT + (size_t)(dst_row0 + n) * ldk + dst_k0 + 8 * c) = o; }
    asm volatile("s_waitcnt lgkmcnt(0)" ::: "memory");
}
__device__ __forceinline__ void transpose_matrix_item(const float* W, int K, int ldn, int Ndst, int mode, bf16_t* WT, int ldk, int dst_k0, LAS float* scr, int item, int lane) {
    const int nnb = Ndst / 32, kb = item / nnb, nb = item % nnb, n0 = nb * 32;
    const int j = lane & 31; int src;
    if (mode == 1) { const int t = n0 >> 8, r = n0 & 255; src = ((r < 128) ? (128 * t + r) : (FF + 128 * t + (r - 128))) + j; }
    else if (mode == 2) {
        if (n0 < 2816) src = n0 + (n0 >= 768 ? 4 : 0) + j;
        else {
            const int gl = n0 - 2816, T = gl >> 8, l0 = gl & 255, bj = l0 >> 7, wc = (l0 >> 5) & 3, fq = j >> 3, n = (j >> 2) & 1, e = j & 3;
            src = 2820 + 1024 * (2 * bj + n) + 64 * T + 16 * wc + 4 * fq + e;
        }
    }
    else src = n0 + j;
    transpose_item(W, ldn, kb * 64, src, WT, ldk, n0, dst_k0 + kb * 64, scr, lane);
}
__device__ __forceinline__ void wconv_phase(const CAS Args* a, int L, int part, LAS unsigned char* lds, int gw, int NGW, int wave, int lane) {
    LAS float* scr = (LAS float*)(lds + wave * 16384);
    unsigned char* ws = a->ws + ((L & 1) ? WS_WB - WS_W : 0);
    const float* gu1 = a->in[3] + (size_t)L * DM * 2 * FF; const float* d1 = a->in[4] + (size_t)L * FF * DM; const float* win = a->in[7] + (size_t)L * DM * NIN;
    const float* bra = a->in[17] + (size_t)L * 256 * DM; const float* brb = a->in[18] + (size_t)L * 256 * DM; const float* brc = a->in[19] + (size_t)L * 256 * DM; const float* brd = a->in[20] + (size_t)L * 512 * DM;
    const float* wo = a->in[21] + (size_t)L * DM * DM; const float* gu2 = a->in[24] + (size_t)L * DM * 2 * FF; const float* d2 = a->in[25] + (size_t)L * FF * DM;
    const float* wpg = a->in[28] + (size_t)L * DM * DM; const float* wple = a->in[29] + (size_t)L * PLE * DM;
    constexpr int I_GU = (DM / 64) * (2 * FF / 32), I_D = (FF / 64) * (DM / 32), I_IN = (DM / 64) * (NPROJ / 32), I_BR = (256 / 64) * (DM / 32), I_BRD = (512 / 64) * (DM / 32), I_SQ = (DM / 64) * (DM / 32), I_PLE = (PLE / 64) * (DM / 32);
    constexpr int NITEMS = 2 * I_GU + 2 * I_D + I_IN + 3 * I_BR + I_BRD + 2 * I_SQ + I_PLE;
    const int it_lo = (part == 1) ? NITEMS / 2 : 0, it_hi = (part == 0) ? NITEMS / 2 : NITEMS;
    for (int it = it_lo + gw; it < it_hi; it += NGW) {
        int r = it;
        if (r < I_GU) { transpose_matrix_item(gu1, DM, 2 * FF, 2 * FF, 1, (bf16_t*)(ws + W_GU1), DM, 0, scr, r, lane); continue; } r -= I_GU;
        if (r < I_GU) { transpose_matrix_item(gu2, DM, 2 * FF, 2 * FF, 1, (bf16_t*)(ws + W_GU2), DM, 0, scr, r, lane); continue; } r -= I_GU;
        if (r < I_D) { transpose_matrix_item(d1, FF, DM, DM, 0, (bf16_t*)(ws + W_D1), FF, 0, scr, r, lane); continue; } r -= I_D;
        if (r < I_D) { transpose_matrix_item(d2, FF, DM, DM, 0, (bf16_t*)(ws + W_D2), FF, 0, scr, r, lane); continue; } r -= I_D;
        if (r < I_IN) { transpose_matrix_item(win, DM, NIN, NPROJ, 2, (bf16_t*)(ws + W_IN), DM, 0, scr, r, lane); continue; } r -= I_IN;
        if (r < I_BR) { transpose_matrix_item(bra, 256, DM, DM, 0, (bf16_t*)(ws + W_BR), YW, 0, scr, r, lane); continue; } r -= I_BR;
        if (r < I_BR) { transpose_matrix_item(brb, 256, DM, DM, 0, (bf16_t*)(ws + W_BR), YW, 256, scr, r, lane); continue; } r -= I_BR;
        if (r < I_BR) { transpose_matrix_item(brc, 256, DM, DM, 0, (bf16_t*)(ws + W_BR), YW, 512, scr, r, lane); continue; } r -= I_BR;
        if (r < I_BRD) { transpose_matrix_item(brd, 512, DM, DM, 0, (bf16_t*)(ws + W_BR), YW, 768, scr, r, lane); continue; } r -= I_BRD;
        if (r < I_SQ) { transpose_matrix_item(wo, DM, DM, DM, 0, (bf16_t*)(ws + W_O), DM, 0, scr, r, lane); continue; } r -= I_SQ;
        if (r < I_SQ) { transpose_matrix_item(wpg, DM, DM, DM, 0, (bf16_t*)(ws + W_PG), DM, 0, scr, r, lane); continue; } r -= I_SQ;
        transpose_matrix_item(wple, PLE, DM, DM, 0, (bf16_t*)(ws + W_PLE), PLE, 0, scr, r, lane);
    }
    float* af = (float*)(ws + W_AF);
    if (part != 1) for (int i = gw * 64 + lane; i < DM * 4; i += NGW * 64) af[i] = win[(size_t)(i >> 2) * NIN + 768 + (i & 3)];
}

__device__ __forceinline__ float log_sigmoid_f(float x) { return fminf(x, 0.f) - log1pf(expf(-fabsf(x))); }
typedef _Float16 h16x2 __attribute__((ext_vector_type(2)));
__device__ __forceinline__ unsigned pkh(float a, float b) { h16x2 v; v.x = (_Float16)a; v.y = (_Float16)b; return __builtin_bit_cast(unsigned, v); }
__device__ __forceinline__ float hlo(unsigned w) { return (float)__builtin_bit_cast(h16x2, w).x; }
__device__ __forceinline__ float hhi(unsigned w) { return (float)__builtin_bit_cast(h16x2, w).y; }
struct RowArgs { const float* hin32; const unsigned short* hin16; float* hout32; unsigned short* hout16; const bf16_t* F; const bf16_t* F2; const float* gpost; float scale; const float* gnext; bf16_t* U; const float* AF; const float* bforget; float* LOGF; const float* p; bf16_t* Pbf; };
struct RowRaw { f32x4 v32[2][2]; u32x4 v16[2]; u32x4 f[2]; u32x4 e[2]; f32x4 p; };
__device__ __forceinline__ void row_load(const RowArgs& R, int m, int lane, RowRaw& q) {
    const size_t off = (size_t)m * DM + 8 * lane;
    if (R.hin32) {
#pragma unroll
        for (int j = 0; j < 2; ++j) { q.v32[j][0] = __builtin_nontemporal_load((const f32x4*)(R.hin32 + off + 512 * j)); q.v32[j][1] = __builtin_nontemporal_load((const f32x4*)(R.hin32 + off + 512 * j + 4)); }
    } else {
#pragma unroll
        for (int j = 0; j < 2; ++j) q.v16[j] = __builtin_nontemporal_load((const u32x4*)(R.hin16 + off + 512 * j));
    }
    if (R.F) {
#pragma unroll
        for (int j = 0; j < 2; ++j) q.f[j] = __builtin_nontemporal_load((const u32x4*)(R.F + off + 512 * j));
    }
    if (R.F2) {
#pragma unroll
        for (int j = 0; j < 2; ++j) q.e[j] = __builtin_nontemporal_load((const u32x4*)(R.F2 + off + 512 * j));
    }
    if (R.p) q.p = __builtin_nontemporal_load((const f32x4*)(R.p + (size_t)m * PLE + 4 * lane));
}
#define UNPK_BF(dst, SRC_) do { const u32x4 t_ = (SRC_); dst[0] = bflo(t_.x); dst[1] = bfhi(t_.x); dst[2] = bflo(t_.y); dst[3] = bfhi(t_.y); dst[4] = bflo(t_.z); dst[5] = bfhi(t_.z); dst[6] = bflo(t_.w); dst[7] = bfhi(t_.w); } while (0)
__device__ __forceinline__ void row_process(const RowArgs& R, int m, int lane, const RowRaw& q, const float (&gp)[2][8], const float (&gn)[2][8], const f32x4 bf) {
    const size_t off = (size_t)m * DM + 8 * lane;
    float v[2][8];
    if (R.hin32) {
#pragma unroll
        for (int j = 0; j < 2; ++j)
#pragma unroll
            for (int e = 0; e < 4; ++e) { v[j][e] = q.v32[j][0][e]; v[j][4 + e] = q.v32[j][1][e]; }
    } else {
#pragma unroll
        for (int j = 0; j < 2; ++j) { const u32x4 w = q.v16[j]; v[j][0] = hlo(w.x); v[j][1] = hhi(w.x); v[j][2] = hlo(w.y); v[j][3] = hhi(w.y); v[j][4] = hlo(w.z); v[j][5] = hhi(w.z); v[j][6] = hlo(w.w); v[j][7] = hhi(w.w); }
    }
    if (R.F) {
        float f[2][8];
#pragma unroll
        for (int j = 0; j < 2; ++j) UNPK_BF(f[j], q.f[j]);
        if (R.F2) {
            float e[2][8]; float ss = 0.f;
#pragma unroll
            for (int j = 0; j < 2; ++j) { UNPK_BF(e[j], q.e[j]);
#pragma unroll
                for (int c = 0; c < 8; ++c) ss += e[j][c] * e[j][c]; }
            const float r = 1.0f / sqrtf(wave_sum(ss) * (1.0f / DM) + EPS);
#pragma unroll
            for (int j = 0; j < 2; ++j)
#pragma unroll
                for (int c = 0; c < 8; ++c) v[j][c] += (1.0f / (1.0f + expf(-f[j][c]))) * (e[j][c] * r * gp[j][c]);
        } else {
            float ss = 0.f;
#pragma unroll
            for (int j = 0; j < 2; ++j)
#pragma unroll
                for (int c = 0; c < 8; ++c) ss += f[j][c] * f[j][c];
            const float r = 1.0f / sqrtf(wave_sum(ss) * (1.0f / DM) + EPS);
#pragma unroll
            for (int j = 0; j < 2; ++j)
#pragma unroll
                for (int c = 0; c < 8; ++c) v[j][c] += R.scale * ((f[j][c] * r) * gp[j][c]);
        }
        if (R.hout32) {
#pragma unroll
            for (int j = 0; j < 2; ++j) { __builtin_nontemporal_store((f32x4){v[j][0], v[j][1], v[j][2], v[j][3]}, (f32x4*)(R.hout32 + off + 512 * j)); __builtin_nontemporal_store((f32x4){v[j][4], v[j][5], v[j][6], v[j][7]}, (f32x4*)(R.hout32 + off + 512 * j + 4)); }
        } else {
#pragma unroll
            for (int j = 0; j < 2; ++j) {
                u32x4 w; w.x = pkh(v[j][0], v[j][1]); w.y = pkh(v[j][2], v[j][3]); w.z = pkh(v[j][4], v[j][5]); w.w = pkh(v[j][6], v[j][7]);
                __builtin_nontemporal_store(w, (u32x4*)(R.hout16 + off + 512 * j));
                v[j][0] = hlo(w.x); v[j][1] = hhi(w.x); v[j][2] = hlo(w.y); v[j][3] = hhi(w.y); v[j][4] = hlo(w.z); v[j][5] = hhi(w.z); v[j][6] = hlo(w.w); v[j][7] = hhi(w.w);
            }
        }
    }
    if (R.gnext) {
        float ss = 0.f;
#pragma unroll
        for (int j = 0; j < 2; ++j)
#pragma unroll
            for (int c = 0; c < 8; ++c) ss += v[j][c] * v[j][c];
        const float r2 = 1.0f / sqrtf(wave_sum(ss) * (1.0f / DM) + EPS);
        float un[2][8];
#pragma unroll
        for (int j = 0; j < 2; ++j) {
#pragma unroll
            for (int c = 0; c < 8; ++c) un[j][c] = (v[j][c] * r2) * gn[j][c];
            u32x4 w; w.x = pk2(un[j][0], un[j][1]); w.y = pk2(un[j][2], un[j][3]); w.z = pk2(un[j][4], un[j][5]); w.w = pk2(un[j][6], un[j][7]);
            *(u32x4*)(R.U + off + 512 * j) = w;
        }
        if (R.AF) {
            f32x4 acc = {0.f, 0.f, 0.f, 0.f};
#pragma unroll
            for (int j = 0; j < 2; ++j)
#pragma unroll
                for (int c = 0; c < 8; ++c) acc = acc + un[j][c] * *(const f32x4*)(R.AF + (size_t)(8 * lane + 512 * j + c) * 4);
            acc[0] = wave_sum(acc[0]); acc[1] = wave_sum(acc[1]); acc[2] = wave_sum(acc[2]); acc[3] = wave_sum(acc[3]);
            if (lane == 0) { f32x4 o; o[0] = log_sigmoid_f(acc[0] + bf[0]); o[1] = log_sigmoid_f(acc[1] + bf[1]); o[2] = log_sigmoid_f(acc[2] + bf[2]); o[3] = log_sigmoid_f(acc[3] + bf[3]); *(f32x4*)(R.LOGF + (size_t)m * 4) = o; }
        }
    }
    if (R.p) { u32x2 w; w.x = pk2(q.p[0], q.p[1]); w.y = pk2(q.p[2], q.p[3]); *(u32x2*)(R.Pbf + (size_t)m * PLE + 4 * lane) = w; }
}
__device__ __forceinline__ void row_pass(const RowArgs& R, int gw, int NGW, int lane) {
    float gp[2][8], gn[2][8];
#pragma unroll
    for (int j = 0; j < 2; ++j)
#pragma unroll
        for (int h = 0; h < 2; ++h) {
            const f32x4 a = R.gpost ? *(const f32x4*)(R.gpost + 8 * lane + 512 * j + 4 * h) : (f32x4){0.f, 0.f, 0.f, 0.f};
            const f32x4 b = R.gnext ? *(const f32x4*)(R.gnext + 8 * lane + 512 * j + 4 * h) : (f32x4){0.f, 0.f, 0.f, 0.f};
#pragma unroll
            for (int e = 0; e < 4; ++e) { gp[j][4 * h + e] = a[e]; gn[j][4 * h + e] = b[e]; }
        }
    const f32x4 bf = R.AF ? *(const f32x4*)R.bforget : (f32x4){0.f, 0.f, 0.f, 0.f};
    RowRaw qa, qb;
    if (gw < M) row_load(R, gw, lane, qa);
    for (int m = gw; m < M; m += 2 * NGW) {
        const int m1 = m + NGW, m2 = m + 2 * NGW;
        if (m1 < M) row_load(R, m1, lane, qb);
        row_process(R, m, lane, qa, gp, gn, bf);
        if (m2 < M) row_load(R, m2, lane, qa);
        if (m1 < M) row_process(R, m1, lane, qb, gp, gn, bf);
    }
}
__device__ __forceinline__ void cumsum_seq(const float* LOGF, float* CUM, int seq, int lane) {
    const int b = seq >> 2, h = seq & 3; const size_t base = ((size_t)b * SEQ + 32 * lane) * 4 + h;
    float s = 0.f;
#pragma unroll 8
    for (int i = 0; i < 32; ++i) s += LOGF[base + 4 * i];
    float incl = s;
#pragma unroll
    for (int o = 1; o < 64; o <<= 1) { const float n = __shfl_up(incl, o); if (lane >= o) incl += n; }
    float run = incl - s;
#pragma unroll 8
    for (int i = 0; i < 32; ++i) { run += LOGF[base + 4 * i]; CUM[base + 4 * i] = run * LOG2E; }
}

__device__ __forceinline__ int crow(int r, int hi) { return (r & 3) + 8 * (r >> 2) + 4 * hi; }
__device__ __forceinline__ int kvperm(int kv) { return (kv & 0x33) | (((kv >> 2) & 1) << 3) | (((kv >> 3) & 1) << 2); }
constexpr int KROW = 144;
constexpr float ATT_THR = 8.0f;
template <int TYPE>
__device__ __forceinline__ void attn_tile(f32x16 (&o)[2], float& m, float& l, const bf16x8 (&qr)[4], const LAS unsigned char* Kt, const LAS unsigned char* VTt, int vt_stride,
                                          int kv0, int qpos, float cq, const LAS float* ckv, const LAS float* biasT, bool domask, bool first, int r32, int hi) {
    f32x16 p0, p1;
    if (TYPE == 0) {
        const float cb = cq - m;
#pragma unroll
        for (int g = 0; g < 4; ++g) {
            const f32x4 c0 = *(const LAS f32x4*)(ckv + 8 * g + 4 * hi), c1 = *(const LAS f32x4*)(ckv + 32 + 8 * g + 4 * hi);
#pragma unroll
            for (int e = 0; e < 4; ++e) { p0[4 * g + e] = cb - c0[e]; p1[4 * g + e] = cb - c1[e]; }
        }
    } else {
#pragma unroll
        for (int r = 0; r < 16; ++r) { const int d0 = qpos - (kv0 + crow(r, hi)); p0[r] = biasT[d0 & 127] - m; p1[r] = biasT[(d0 - 32) & 127] - m; }
    }
    const LAS unsigned char* kp = Kt + r32 * KROW + 16 * hi;
#pragma unroll
    for (int d0 = 0; d0 < 4; ++d0) {
        const bf16x8 a0 = *(const LAS bf16x8*)(kp + 32 * d0), a1 = *(const LAS bf16x8*)(kp + 32 * KROW + 32 * d0);
        p0 = __builtin_amdgcn_mfma_f32_32x32x16_bf16(a0, qr[d0], p0, 0, 0, 0);
        p1 = __builtin_amdgcn_mfma_f32_32x32x16_bf16(a1, qr[d0], p1, 0, 0, 0);
    }
    if (TYPE == 0) {
        if (domask) {
#pragma unroll
            for (int r = 0; r < 16; ++r) { const int kv = kv0 + crow(r, hi); if (kv > qpos) p0[r] = NEGBIG; if (kv + 32 > qpos) p1[r] = NEGBIG; }
        }
    } else {
#pragma unroll
        for (int r = 0; r < 16; ++r) { const int d0 = qpos - (kv0 + crow(r, hi)), d1 = d0 - 32; if ((unsigned)d0 >= 128u) p0[r] = NEGBIG; if ((unsigned)d1 >= 128u) p1[r] = NEGBIG; }
    }
    float mx = fmaxf(p0[0], p1[0]);
#pragma unroll
    for (int r = 1; r < 16; ++r) mx = fmaxf(mx, fmaxf(p0[r], p1[r]));
    { const auto rr = __builtin_amdgcn_permlane32_swap(__float_as_uint(mx), __float_as_uint(mx), false, false); mx = fmaxf(__uint_as_float(rr[0]), __uint_as_float(rr[1])); }
    const bool need = first || (mx > ATT_THR);
    if (__any(need)) {
        const float dl = need ? mx : 0.f, alpha = __builtin_amdgcn_exp2f(-dl);
        m += dl; l *= alpha;
#pragma unroll
        for (int r = 0; r < 16; ++r) { p0[r] -= dl; p1[r] -= dl; o[0][r] *= alpha; o[1][r] *= alpha; }
    }
    float s = 0.f;
#pragma unroll
    for (int r = 0; r < 16; ++r) { p0[r] = __builtin_amdgcn_exp2f(p0[r]); p1[r] = __builtin_amdgcn_exp2f(p1[r]); s += p0[r] + p1[r]; }
    l += s;
    bf16x8 pf[4];
    { u32x4 w;
      w.x = cvt_pk_bf16(p0[0], p0[1]); w.y = cvt_pk_bf16(p0[2], p0[3]); w.z = cvt_pk_bf16(p0[4], p0[5]); w.w = cvt_pk_bf16(p0[6], p0[7]); pf[0] = __builtin_bit_cast(bf16x8, w);
      w.x = cvt_pk_bf16(p0[8], p0[9]); w.y = cvt_pk_bf16(p0[10], p0[11]); w.z = cvt_pk_bf16(p0[12], p0[13]); w.w = cvt_pk_bf16(p0[14], p0[15]); pf[1] = __builtin_bit_cast(bf16x8, w);
      w.x = cvt_pk_bf16(p1[0], p1[1]); w.y = cvt_pk_bf16(p1[2], p1[3]); w.z = cvt_pk_bf16(p1[4], p1[5]); w.w = cvt_pk_bf16(p1[6], p1[7]); pf[2] = __builtin_bit_cast(bf16x8, w);
      w.x = cvt_pk_bf16(p1[8], p1[9]); w.y = cvt_pk_bf16(p1[10], p1[11]); w.z = cvt_pk_bf16(p1[12], p1[13]); w.w = cvt_pk_bf16(p1[14], p1[15]); pf[3] = __builtin_bit_cast(bf16x8, w); }
#pragma unroll
    for (int db = 0; db < 2; ++db) {
        const LAS unsigned char* vp = VTt + (32 * db + r32) * vt_stride + 16 * hi;
#pragma unroll
        for (int j = 0; j < 4; ++j) { const bf16x8 a = *(const LAS bf16x8*)(vp + 32 * j); o[db] = __builtin_amdgcn_mfma_f32_32x32x16_bf16(a, pf[j], o[db], 0, 0, 0); }
    }
}
__device__ __forceinline__ void attn_store(const f32x16 (&o)[2], float l, bf16_t* dst  , int hi) {
    const float lt = l + __shfl_xor(l, 32), inv = 1.0f / lt;
#pragma unroll
    for (int db = 0; db < 2; ++db)
#pragma unroll
        for (int g = 0; g < 4; ++g) { u32x2 w; w.x = cvt_pk_bf16(o[db][4 * g] * inv, o[db][4 * g + 1] * inv); w.y = cvt_pk_bf16(o[db][4 * g + 2] * inv, o[db][4 * g + 3] * inv);
            *(u32x2*)(dst + 32 * db + 8 * g + 4 * hi) = w; }
}

constexpr int AVS = 272, A_K = 0, A_VT = 128 * KROW, A_C = A_VT + 64 * AVS, ABUF = A_C + 512;
__device__ __forceinline__ void attnA_unit(LAS unsigned char* lds, const bf16_t* PROJ, const float* CUM, bf16_t* YCAT, int bg, int bl, int h, int qb, int tid, int wave, int lane) {
    const int r32 = lane & 31, hi = lane >> 5, NS = 2 * (qb + 1), q0w = 256 * qb + 32 * wave, qpos = q0w + r32;
    const size_t prow = (size_t)bl * SEQ, grow = (size_t)bg * SEQ;
    bf16x8 qr[4];
    { const bf16_t* qp = PROJ + (prow + qpos) * NPROJ + 64 * h + 8 * hi;
#pragma unroll
      for (int d0 = 0; d0 < 4; ++d0) qr[d0] = *(const bf16x8*)(qp + 16 * d0); }
    const float cq = CUM[(grow + qpos) * 4 + h];
    const int lrow = tid >> 3, lch = tid & 7;
    const bf16_t* kg = PROJ + (prow + lrow) * NPROJ + 256 + 64 * h + 8 * lch;
    const bf16_t* vg = PROJ + (prow + 2 * lane) * NPROJ + 512 + 64 * h + 8 * wave;
    const float* cgp = CUM + (grow + (tid & 127)) * 4 + h;
    const int kst = A_K + lrow * KROW + lch * 16;
    const int vpos = 64 * ((2 * lane) >> 6) + kvperm((2 * lane) & 63), vst = A_VT + (8 * wave) * AVS + vpos * 2;
    u32x4 k0, k1, va, vb; float creg = 0.f;
#define A_LOAD(st) do { const size_t ro = (size_t)(st) * 128 * NPROJ; k0 = *(const u32x4*)(kg + ro); k1 = *(const u32x4*)(kg + ro + (size_t)64 * NPROJ); \
        va = *(const u32x4*)(vg + ro); vb = *(const u32x4*)(vg + ro + NPROJ); if (tid < 128) creg = cgp[(size_t)(st) * 128 * 4]; } while (0)
#define A_STORE(buf) do { LAS unsigned char* bb = lds + (buf) * ABUF; *(LAS u32x4*)(bb + kst) = k0; *(LAS u32x4*)(bb + kst + 64 * KROW) = k1; \
        LAS unsigned* vv = (LAS unsigned*)(bb + vst); \
        vv[0 * (AVS / 4)] = (va.x & 0xffffu) | (vb.x << 16); vv[1 * (AVS / 4)] = (va.x >> 16) | (vb.x & 0xffff0000u); \
        vv[2 * (AVS / 4)] = (va.y & 0xffffu) | (vb.y << 16); vv[3 * (AVS / 4)] = (va.y >> 16) | (vb.y & 0xffff0000u); \
        vv[4 * (AVS / 4)] = (va.z & 0xffffu) | (vb.z << 16); vv[5 * (AVS / 4)] = (va.z >> 16) | (vb.z & 0xffff0000u); \
        vv[6 * (AVS / 4)] = (va.w & 0xffffu) | (vb.w << 16); vv[7 * (AVS / 4)] = (va.w >> 16) | (vb.w & 0xffff0000u); \
        if (tid < 128) *(LAS float*)(bb + A_C + 4 * tid) = creg; } while (0)
    f32x16 o[2];
#pragma unroll
    for (int r = 0; r < 16; ++r) { o[0][r] = 0.f; o[1][r] = 0.f; }
    float m = 0.f, l = 0.f;
    const int t0w = (q0w + 31) >> 6;
    A_LOAD(NS - 1); A_STORE(0); __syncthreads();
    for (int it = 0; it < NS; ++it) {
        const int st = NS - 1 - it;
        if (it + 1 < NS) A_LOAD(st - 1);
        const LAS unsigned char* bb = lds + (it & 1) * ABUF;
#pragma unroll
        for (int sub = 1; sub >= 0; --sub) {
            const int t = 2 * st + sub;
            if (t <= t0w)
                attn_tile<0>(o, m, l, qr, bb + A_K + sub * 64 * KROW, bb + A_VT + sub * 128, AVS, 64 * t, qpos, cq, (const LAS float*)(bb + A_C) + 64 * sub, (const LAS float*)0, 64 * t + 63 > q0w, t == t0w, r32, hi);
        }
        if (it + 1 < NS) A_STORE((it + 1) & 1);
        __syncthreads();
    }
#undef A_LOAD
#undef A_STORE
    attn_store(o, l, YCAT + (grow + qpos) * YW + 64 * h, hi);
}
constexpr int D_K = 0, D_VT = 4 * 64 * KROW, D_VSTRIDE = 528, D_BIAS = D_VT + 64 * D_VSTRIDE, D_END = D_BIAS + 4 * 128 * 4;
__device__ __forceinline__ void attnD_unit(LAS unsigned char* lds, const bf16_t* PROJ, bf16_t* YCAT, const float* relb, const float* sinks, const CAS unsigned char* bucket, int bg, int bl, int kvh, int n, int tid, int wave, int lane) {
    const int r32 = lane & 31, hi = lane >> 5;
    const size_t prow = (size_t)bl * SEQ, grow = (size_t)bg * SEQ;
#pragma unroll
    for (int it = 0; it < 4; ++it) {
        const int idx = tid + 512 * it, i = idx >> 3, ch = idx & 7, pos = 128 * (n - 1) + i;
        if (pos >= 0) *(LAS u32x4*)(lds + D_K + (i >> 6) * (64 * KROW) + (i & 63) * KROW + ch * 16) = *(const u32x4*)(PROJ + (prow + pos) * NPROJ + 2560 + 64 * kvh + 8 * ch);
    }
#pragma unroll
    for (int it = 0; it < 2; ++it) {
        const int i = 2 * (lane + 64 * it), pos = 128 * (n - 1) + i;
        if (pos >= 0) {
            const bf16_t* src = PROJ + (prow + pos) * NPROJ + 2688 + 64 * kvh + 8 * wave;
            const u32x4 va = *(const u32x4*)src, vb = *(const u32x4*)(src + NPROJ);
            LAS unsigned* vv = (LAS unsigned*)(lds + D_VT + (8 * wave) * D_VSTRIDE + ((i >> 6) * 64 + kvperm(i & 63)) * 2);
            vv[0 * (D_VSTRIDE / 4)] = (va.x & 0xffffu) | (vb.x << 16); vv[1 * (D_VSTRIDE / 4)] = (va.x >> 16) | (vb.x & 0xffff0000u);
            vv[2 * (D_VSTRIDE / 4)] = (va.y & 0xffffu) | (vb.y << 16); vv[3 * (D_VSTRIDE / 4)] = (va.y >> 16) | (vb.y & 0xffff0000u);
            vv[4 * (D_VSTRIDE / 4)] = (va.z & 0xffffu) | (vb.z << 16); vv[5 * (D_VSTRIDE / 4)] = (va.z >> 16) | (vb.z & 0xffff0000u);
            vv[6 * (D_VSTRIDE / 4)] = (va.w & 0xffffu) | (vb.w << 16); vv[7 * (D_VSTRIDE / 4)] = (va.w >> 16) | (vb.w & 0xffff0000u);
        }
    }
    { const int g = tid >> 7, dist = tid & 127; ((LAS float*)(lds + D_BIAS))[tid] = relb[(int)bucket[dist] * 8 + 4 * kvh + g] * LOG2E; }
    __syncthreads();
#pragma unroll 1
    for (int k = wave; k < 16; k += 8) {
        const int g = k >> 2, j = k & 3, hq = 4 * kvh + g, qpos = 128 * n + 32 * j + r32;
        bf16x8 qr[4];
        { const bf16_t* qp = PROJ + (prow + qpos) * NPROJ + 2048 + 64 * hq + 8 * hi;
#pragma unroll
          for (int d0 = 0; d0 < 4; ++d0) qr[d0] = *(const bf16x8*)(qp + 16 * d0); }
        f32x16 o[2];
#pragma unroll
        for (int r = 0; r < 16; ++r) { o[0][r] = 0.f; o[1][r] = 0.f; }
        float m = sinks[hq] * LOG2E, l = (hi == 0) ? 1.0f : 0.0f;
        int jlo = (j >= 2) ? 1 : 0; const int jhi = (j >= 2) ? 3 : 2; if (n == 0 && jlo < 2) jlo = 2;
        for (int jt = jlo; jt <= jhi; ++jt)
            attn_tile<1>(o, m, l, qr, lds + D_K + jt * (64 * KROW), lds + D_VT + jt * 128, D_VSTRIDE, 128 * (n - 1) + 64 * jt, qpos, 0.f, (const LAS float*)0, (const LAS float*)(lds + D_BIAS) + 128 * g, true, false, r32, hi);
        attn_store(o, l, YCAT + (grow + qpos) * YW + 768 + 64 * hq, hi);
    }
    __syncthreads();
}
constexpr int CW_OFF = 94 * 256 * 4;
__device__ __forceinline__ void conv_weights_to_lds(LAS unsigned char* lds, const float* wdw, int tid) {
    LAS float* w = (LAS float*)(lds + CW_OFF);
#pragma unroll
    for (int it = 0; it < 4; ++it) { const int idx = tid + 512 * it; if (idx < 31 * 64) *(LAS f32x4*)(w + 4 * idx) = *(const f32x4*)(wdw + 4 * idx); }
}
__device__ __forceinline__ void conv_unit(LAS unsigned char* lds, const bf16_t* PROJ, bf16_t* YCAT, const float* wshort, const float* dwb, const float* lng, const float* lnb, int bg, int bl, int tb, int tid, int wave, int lane) {
    const size_t prow = (size_t)bl * SEQ, grow = (size_t)bg * SEQ; const int t0 = 64 * tb;
    {
        const int grp = tid & 31;
        f32x4 w0[3], w1[3];
#pragma unroll
        for (int k = 0; k < 3; ++k) { w0[k] = *(const f32x4*)(wshort + k * 256 + 8 * grp); w1[k] = *(const f32x4*)(wshort + k * 256 + 8 * grp + 4); }
#pragma unroll 2
        for (int it = 0; it < 4; ++it) {
            const int tok = (tid >> 5) + 16 * it, t = t0 + tok;
            const bf16_t* src = PROJ + (prow + t) * NPROJ + 768 + 8 * grp;
            u32x4 c[3], x[3];
#pragma unroll
            for (int k = 0; k < 3; ++k) {
                const int tt = t - 2 + k;
                if (tt >= 0) { c[k] = *(const u32x4*)(src + (k - 2) * NPROJ + 256); x[k] = *(const u32x4*)(src + (k - 2) * NPROJ + 512); }
                else { c[k] = (u32x4){0u, 0u, 0u, 0u}; x[k] = (u32x4){0u, 0u, 0u, 0u}; }
            }
            const u32x4 b = *(const u32x4*)src;
            float acc[8];
#pragma unroll
            for (int e = 0; e < 8; ++e) acc[e] = 0.f;
#pragma unroll
            for (int k = 0; k < 3; ++k) {
                acc[0] += w0[k][0] * (bflo(c[k].x) * bflo(x[k].x)); acc[1] += w0[k][1] * (bfhi(c[k].x) * bfhi(x[k].x)); acc[2] += w0[k][2] * (bflo(c[k].y) * bflo(x[k].y)); acc[3] += w0[k][3] * (bfhi(c[k].y) * bfhi(x[k].y));
                acc[4] += w1[k][0] * (bflo(c[k].z) * bflo(x[k].z)); acc[5] += w1[k][1] * (bfhi(c[k].z) * bfhi(x[k].z)); acc[6] += w1[k][2] * (bflo(c[k].w) * bflo(x[k].w)); acc[7] += w1[k][3] * (bfhi(c[k].w) * bfhi(x[k].w));
            }
            u32x4 w; w.x = cvt_pk_bf16(bflo(b.x) * acc[0], bfhi(b.x) * acc[1]); w.y = cvt_pk_bf16(bflo(b.y) * acc[2], bfhi(b.y) * acc[3]); w.z = cvt_pk_bf16(bflo(b.z) * acc[4], bfhi(b.z) * acc[5]); w.w = cvt_pk_bf16(bflo(b.w) * acc[6], bfhi(b.w) * acc[7]);
            *(u32x4*)(YCAT + (grow + t) * YW + 256 + 8 * grp) = w;
        }
    }
    LAS float* glu = (LAS float*)lds;
#pragma unroll 3
    for (int it = 0; it < 6; ++it) {
        const int idx = tid + 512 * it;
        if (idx < 94 * 32) {
            const int r = idx >> 5, grp = idx & 31, tt = t0 - 30 + r;
            f32x4 g0 = {0.f, 0.f, 0.f, 0.f}, g1 = {0.f, 0.f, 0.f, 0.f};
            if (tt >= 0) {
                const bf16_t* src = PROJ + (prow + tt) * NPROJ + 1536 + 8 * grp;
                const u32x4 a = *(const u32x4*)src, s = *(const u32x4*)(src + 256);
                g0[0] = bflo(a.x) * sigmoid_f(bflo(s.x)); g0[1] = bfhi(a.x) * sigmoid_f(bfhi(s.x)); g0[2] = bflo(a.y) * sigmoid_f(bflo(s.y)); g0[3] = bfhi(a.y) * sigmoid_f(bfhi(s.y));
                g1[0] = bflo(a.z) * sigmoid_f(bflo(s.z)); g1[1] = bfhi(a.z) * sigmoid_f(bfhi(s.z)); g1[2] = bflo(a.w) * sigmoid_f(bflo(s.w)); g1[3] = bfhi(a.w) * sigmoid_f(bfhi(s.w));
            }
            *(LAS f32x4*)(glu + r * 256 + 8 * grp) = g0; *(LAS f32x4*)(glu + r * 256 + 8 * grp + 4) = g1;
        }
    }
    __syncthreads();
    {
        f32x4 acc[8];
#pragma unroll
        for (int i = 0; i < 8; ++i) acc[i] = (f32x4){0.f, 0.f, 0.f, 0.f};
        const LAS float* gb = glu + (8 * wave) * 256 + 4 * lane;
        const LAS float* wl = (const LAS float*)(lds + CW_OFF) + 4 * lane;
#pragma unroll 2
        for (int k = 0; k < 31; ++k) {
            const f32x4 wk = *(const LAS f32x4*)(wl + k * 256);
#pragma unroll
            for (int i = 0; i < 8; ++i) acc[i] = acc[i] + wk * *(const LAS f32x4*)(gb + (i + k) * 256);
        }
        const f32x4 bias = *(const f32x4*)(dwb + 4 * lane), gain = *(const f32x4*)(lng + 4 * lane), lb = *(const f32x4*)(lnb + 4 * lane);
#pragma unroll
        for (int i = 0; i < 8; ++i) {
            const f32x4 v = acc[i] + bias;
            const float mean = wave_sum((v[0] + v[1]) + (v[2] + v[3])) * (1.0f / 256.0f);
            const f32x4 d = v - mean;
            const float var = wave_sum((d[0] * d[0] + d[1] * d[1]) + (d[2] * d[2] + d[3] * d[3])) * (1.0f / 256.0f);
            const float rs = 1.0f / sqrtf(var + EPS);
            f32x4 y = (d * rs) * gain + lb;
#pragma unroll
            for (int e = 0; e < 4; ++e) y[e] = y[e] * sigmoid_f(y[e]);
            u32x2 w; w.x = cvt_pk_bf16(y[0], y[1]); w.y = cvt_pk_bf16(y[2], y[3]);
            *(u32x2*)(YCAT + (grow + t0 + 8 * wave + i) * YW + 512 + 4 * lane) = w;
        }
    }
    __syncthreads();
}
__device__ __forceinline__ void mixer_phase(const CAS Args* a, int L, int half, LAS unsigned char* lds, int bid, int tid, int wave, int lane) {
    const bf16_t* PROJ = (const bf16_t*)(a->ws + WS_PROJ); bf16_t* YCAT = (bf16_t*)(a->ws + WS_YCAT); const float* CUM = (const float*)(a->ws + WS_CUM);
    const int G = gridDim.x, B0 = 16 * half;
    for (int u = bid; u < 256; u += G) {
        const int bl = u >> 4, h = (u >> 2) & 3, pr = u & 3;
        attnA_unit(lds, PROJ, CUM, YCAT, B0 + bl, bl, h, 7 - pr, tid, wave, lane);
        attnA_unit(lds, PROJ, CUM, YCAT, B0 + bl, bl, h, pr, tid, wave, lane);
    }
    for (int u = bid; u < 512; u += G) {
        const int bl = u >> 5, kvh = (u >> 4) & 1, n = u & 15;
        attnD_unit(lds, PROJ, YCAT, a->in[16], a->in[15] + L * 8, a->bucket, B0 + bl, bl, kvh, n, tid, wave, lane);
    }
    conv_weights_to_lds(lds, a->in[11] + (size_t)L * 31 * 256, tid);
    for (int u = bid; u < 512; u += G) {
        const int bl = u >> 5, tb = u & 31;
        conv_unit(lds, PROJ, YCAT, a->in[10] + (size_t)L * 3 * 256, a->in[12] + L * 256, a->in[13] + L * 256, a->in[14] + L * 256, B0 + bl, bl, tb, tid, wave, lane);
    }
}

#define XB_TMO      128
#define XB_XCNT(j)  (256  + 64 * (j))
#define XB_XSUB(j)  (1280 + 64 * (j))
#define XB_XGEN(j)  (2304 + 64 * (j))
#define XB_TOP      3328
#define XB_TOPGEN   3392
#define XCD_BAR_WORDS 3456
#define XB_SPIN_CAP (1u << 22)

__device__ __forceinline__ unsigned xb_ld(unsigned* p)              { return __hip_atomic_load(p, __ATOMIC_RELAXED, __HIP_MEMORY_SCOPE_AGENT); }
__device__ __forceinline__ unsigned xb_add(unsigned* p, unsigned v) { return __hip_atomic_fetch_add(p, v, __ATOMIC_RELAXED, __HIP_MEMORY_SCOPE_AGENT); }
__device__ __forceinline__ unsigned xb_xcc_id() { return (unsigned)__builtin_amdgcn_s_getreg((3 << 11) | 20) & 0xFu; }
#define XB_SPIN(cond, bar) do { unsigned _sp = 0; while (cond) { __builtin_amdgcn_s_sleep(1); \
    if ((++_sp & 255u) == 0u) { if (xb_ld(&(bar)[XB_TMO])) break; if (_sp > XB_SPIN_CAP) { atomicAdd(&(bar)[XB_TMO], 1u); break; } } } } while (0)

struct XcdBarrier {
    unsigned* bar; unsigned x;
    volatile LAS unsigned* st;
};

__device__ __forceinline__ XcdBarrier xcd_barrier_post(unsigned* bar, volatile LAS unsigned* st) {
    XcdBarrier b; b.bar = bar; b.x = xb_xcc_id(); b.st = st;
    if (threadIdx.x == 0) (void)xb_add(&bar[XB_XCNT(b.x)], 1u);
    return b;
}
__device__ __forceinline__ void xcd_barrier_complete(unsigned* bar, unsigned x, unsigned& nloc, unsigned& nx) {
    const unsigned G = gridDim.x * gridDim.y * gridDim.z;
    unsigned sum, cnt, mine, sp = 0u;
    for (;;) {
        sum = 0u; cnt = 0u; mine = 0u;
#pragma unroll
        for (unsigned j = 0; j < 16; ++j) { const unsigned c = xb_ld(&bar[XB_XCNT(j)]); sum += c; cnt += (c > 0u) ? 1u : 0u; mine = (j == x) ? c : mine; }
        if (sum == G) break;
        __builtin_amdgcn_s_sleep(1);
        if ((++sp & 255u) == 0u) { if (xb_ld(&bar[XB_TMO])) break; if (sp > XB_SPIN_CAP) { atomicAdd(&bar[XB_TMO], 1u); break; } }
    }
    nloc = mine > 0u ? mine : 1u; nx = cnt > 0u ? cnt : 1u;
}

__device__ __forceinline__ void xcd_barrier(const XcdBarrier& b) {
    asm volatile("s_waitcnt vmcnt(0)" ::: "memory");
    __syncthreads();
    if (threadIdx.x == 0) {
        unsigned* bar = b.bar;
        __builtin_amdgcn_s_waitcnt(0);
        unsigned nloc = b.st[0], nx = b.st[1];
        if (nloc == 0u) { xcd_barrier_complete(bar, b.x, nloc, nx); b.st[0] = nloc; b.st[1] = nx; }
        const unsigned old = xb_add(&bar[XB_XSUB(b.x)], 1u);
        const unsigned gen = old / nloc;
        if (old + 1u == (gen + 1u) * nloc) {
            __builtin_amdgcn_fence(__ATOMIC_RELEASE, "agent");
            asm volatile("s_waitcnt vmcnt(0)" ::: "memory");
            const unsigned og = xb_add(&bar[XB_TOP], 1u);
            const unsigned tg = og / nx;
            if (og + 1u == (tg + 1u) * nx) xb_add(&bar[XB_TOPGEN], 1u);
            else XB_SPIN(xb_ld(&bar[XB_TOPGEN]) == tg, bar);
            __builtin_amdgcn_fence(__ATOMIC_ACQUIRE, "agent");
            xb_add(&bar[XB_XGEN(b.x)], 1u);
            asm volatile("s_waitcnt vmcnt(0)" ::: "memory");
        } else {
            XB_SPIN(xb_ld(&bar[XB_XGEN(b.x)]) == gen, bar);
            __builtin_amdgcn_fence(__ATOMIC_ACQUIRE, "agent");
            asm volatile("s_waitcnt vmcnt(0)" ::: "memory");
        }
    }
    __syncthreads();
}

__global__ void __launch_bounds__(NTHREADS, 2) mega(Args a_) {
    extern __shared__ __attribute__((aligned(16))) unsigned char lds_raw[];
    LAS unsigned char* lds = (LAS unsigned char*)lds_raw;
    const int ph_lo = a_.ph_lo, ph_hi = a_.ph_hi;
    { volatile LAS unsigned* bst = (volatile LAS unsigned*)(lds + 131072 + 64);
      if (threadIdx.x == 0) { bst[0] = 0u; bst[1] = 0u; }
      __syncthreads();
      (void)xcd_barrier_post((unsigned*)(a_.ws + WS_CTL_BAR), bst); }
    for (int ph = ph_lo; ph < ph_hi; ++ph) {
        const CAS Args* a = (const CAS Args*)__builtin_amdgcn_kernarg_segment_ptr();
        asm volatile("" : "+s"(a));
#define PH_IDS int tid = threadIdx.x; asm volatile("" : "+v"(tid)); const int lane = tid & 63, wave = __builtin_amdgcn_readfirstlane(tid >> 6); int bid = blockIdx.x; asm volatile("" : "+s"(bid)); const int G = gridDim.x, gw = bid * NWAVES + wave, NGW = G * NWAVES; (void)lane; (void)gw; (void)NGW; (void)G;
        unsigned char* ws = a->ws; float* OUT = a->out; unsigned short* H16 = (unsigned short*)(ws + WS_U);
        const int L = ph / PH_PER_LAYER, s = ph % PH_PER_LAYER;
        if (s == 0 && L > 0) continue;
        unsigned char* wsw = ws + ((L & 1) ? WS_WB - WS_W : 0);
        bf16_t* U = (bf16_t*)a->out; bf16_t* HID = (bf16_t*)(ws + WS_HID); bf16_t* F = (bf16_t*)(ws + WS_F); bf16_t* F2 = (bf16_t*)(ws + WS_F2);
        bf16_t* PROJ = (bf16_t*)(ws + WS_PROJ); bf16_t* YCAT = (bf16_t*)(ws + WS_YCAT); bf16_t* MERGED = (bf16_t*)(ws + WS_MERGED);
        float* LOGF = (float*)(ws + WS_LOGF); float* CUM = (float*)(ws + WS_CUM); bf16_t* PBF = (bf16_t*)(ws + WS_PBF);
        if (s == 0) { PH_IDS
            wconv_phase(a, L, -1, lds, gw, NGW, wave, lane);
            if (L == 0) { RowArgs R{a->in[0], nullptr, nullptr, nullptr, nullptr, nullptr, nullptr, 0.f, a->in[2], U, nullptr, nullptr, nullptr, nullptr, nullptr}; row_pass(R, gw, NGW, lane); }
            __syncthreads();
        } else if (s == 1 || s == 12) { PH_IDS
            pg8::Gemm g{U, (const bf16_t*)(wsw + (s == 1 ? W_GU1 : W_GU2)), M, 2 * FF, DM}; pg8::StaticOrder S; S.init(M, 2 * FF, G, bid);
            pg8::EpiSwiglu E{HID, FF};
            pg8::gemm_phase<pg8::EpiSwiglu, pg8::StaticOrder, true, true>(lds, g, S, E);
        } else if (s == 2 || s == 10 || s == 13 || s == 15) { PH_IDS
            const int nrep = (s == 15) ? 2 : 1;
            for (int rep = 0; rep < nrep; ++rep) {
                pg8::Gemm g; bf16_t* out;
                if (s == 2) { g = pg8::Gemm{HID, (const bf16_t*)(wsw + W_D1), M, DM, FF}; out = F; }
                else if (s == 13) { g = pg8::Gemm{HID, (const bf16_t*)(wsw + W_D2), M, DM, FF}; out = F; }
                else if (s == 10) { g = pg8::Gemm{MERGED, (const bf16_t*)(wsw + W_O), M, DM, DM}; out = F; }
                else if (rep == 0) { g = pg8::Gemm{U, (const bf16_t*)(wsw + W_PG), M, DM, DM}; out = F; }
                else { g = pg8::Gemm{PBF, (const bf16_t*)(wsw + W_PLE), M, DM, PLE}; out = F2; }
                pg8::StaticOrder S; S.init(M, DM, G, bid);
                pg8::EpiBf16 E{out, DM};
                pg8::gemm_phase<pg8::EpiBf16, pg8::StaticOrder, true, true>(lds, g, S, E);
            }
        } else if (s == 4 || s == 7) { PH_IDS
            const int half = (s == 7) ? 1 : 0;
            if (half == 0 && wave == 0) { for (int q = bid; q < NB * 4; q += G) cumsum_seq(LOGF, CUM, q, lane); }
            pg8::Gemm g{U + (size_t)half * MH * DM, (const bf16_t*)(wsw + W_IN), MH, NPROJ, DM}; pg8::StaticOrder S; S.init(MH, NPROJ, G, bid);
            pg8::EpiProj E{PROJ, NPROJ, a->in[9] + (size_t)L * 4096, QSCALE};
            pg8::gemm_phase<pg8::EpiProj, pg8::StaticOrder, true, true>(lds, g, S, E);
        } else if (s == 5 || s == 8) { PH_IDS
            mixer_phase(a, L, (s == 8) ? 1 : 0, lds, bid, tid, wave, lane);
            if (L + 1 < DEPTH) wconv_phase(a, L + 1, (s == 8) ? 1 : 0, lds, gw, NGW, wave, lane);
        } else if (s == 6 || s == 9) { PH_IDS
            const int half = (s == 9) ? 1 : 0;
            pg8::Gemm g{YCAT + (size_t)half * MH * YW, (const bf16_t*)(wsw + W_BR), MH, DM, YW}; pg8::StaticOrder S; S.init(MH, DM, G, bid);
            pg8::EpiMerge E{MERGED + (size_t)half * MH * DM, DM, PROJ + 2816, NPROJ};
            pg8::gemm_phase<pg8::EpiMerge, pg8::StaticOrder, true, true>(lds, g, S, E);
        } else { PH_IDS
            RowArgs R;
            const bool last = (L + 1 == DEPTH);
            if (s == 3)       R = RowArgs{L == 0 ? a->in[0] : nullptr, H16, nullptr, H16, F, nullptr, a->in[5] + L * DM, 0.5f, a->in[6] + L * DM, U, (const float*)(wsw + W_AF), a->in[8] + L * 4, LOGF, nullptr, nullptr};
            else if (s == 11) R = RowArgs{nullptr, H16, nullptr, H16, F, nullptr, a->in[22] + L * DM, 1.0f, a->in[23] + L * DM, U, nullptr, nullptr, nullptr, nullptr, nullptr};
            else if (s == 14) R = RowArgs{nullptr, H16, nullptr, H16, F, nullptr, a->in[26] + L * DM, 0.5f, a->in[27] + L * DM, U, nullptr, nullptr, nullptr, a->in[1] + (size_t)L * M * PLE, PBF};
            else              R = RowArgs{nullptr, H16, last ? OUT : nullptr, H16, F, F2, a->in[30] + L * DM, 1.0f, last ? nullptr : a->in[2] + (L + 1) * DM, U, nullptr, nullptr, nullptr, nullptr, nullptr};
            row_pass(R, gw, NGW, lane);
        }
        if (ph + 1 < ph_hi) { if (ph == ph_lo) cg::this_grid().sync(); else { XcdBarrier xbar; xbar.bar = (unsigned*)(a->ws + WS_CTL_BAR); xbar.x = xb_xcc_id(); xbar.st = (volatile LAS unsigned*)(lds + 131072 + 64); xcd_barrier(xbar); } }
    }
}

extern "C" void kernel_launch(void* const* d_in, const int* in_sizes, int n_in, void* d_out, int out_size, void* d_ws, size_t ws_size, hipStream_t stream) {
    static int grid = 0;
    if (grid == 0) {
        if (n_in != 31 || out_size != M * DM || ws_size < WS_NEED) { fprintf(stderr, "kernel_launch: unexpected shapes (n_in %d, out %d, ws %zu)\n", n_in, out_size, ws_size); grid = -1; return; }
        int dev = 0, cus = 0, per_cu = 0;
        if (hipGetDevice(&dev) != hipSuccess || hipDeviceGetAttribute(&cus, hipDeviceAttributeMultiprocessorCount, dev) != hipSuccess) { grid = -1; return; }
        if (hipFuncSetAttribute((const void*)mega, hipFuncAttributeMaxDynamicSharedMemorySize, LDS_BYTES) != hipSuccess) { fprintf(stderr, "kernel_launch: hipFuncSetAttribute failed\n"); grid = -1; return; }
        if (hipOccupancyMaxActiveBlocksPerMultiprocessor(&per_cu, (const void*)mega, NTHREADS, LDS_BYTES) != hipSuccess || per_cu < 1) { fprintf(stderr, "kernel_launch: occupancy query says %d\n", per_cu); per_cu = 1; }
        (void)hipGetLastError();
        grid = cus * per_cu;
        fprintf(stderr, "kernel_launch: grid %d (cus %d x %d)\n", grid, cus, per_cu);
    }
    if (grid < 0) return;
    Args a{};
    for (int i = 0; i < 31; ++i) a.in[i] = (const float*)d_in[i];
    a.out = (float*)d_out; a.ws = (unsigned char*)d_ws;
    for (int d = 0; d < 128; ++d) {
        int bkt;
        if (d < 16) bkt = d;
        else { const float v = logf((float)d / 16.0f) / (float)log(128.0 / 16.0) * 16.0f; bkt = 16 + (int)v; if (bkt > 31) bkt = 31; }
        a.bucket[d] = (unsigned char)bkt;
    }
#if MK_ONE_LAUNCH
    if (hipMemsetAsync(d_ws, 0, CTL_ZERO_BYTES, stream) != hipSuccess) { fprintf(stderr, "kernel_launch: memset failed\n"); return; }
    a.ph_lo = 0; a.ph_hi = N_PHASES;
    void* args[] = {&a};
    hipError_t e = hipLaunchCooperativeKernel((const void*)mega, dim3(grid), dim3(NTHREADS), args, LDS_BYTES, stream);
    if (e != hipSuccess) fprintf(stderr, "kernel_launch: cooperative launch failed: %s (grid %d)\n", hipGetErrorString(e), grid);
#else
    for (int ph = 0; ph < N_PHASES; ++ph) {
        a.ph_lo = ph; a.ph_hi = ph + 1;
        hipLaunchKernelGGL(mega, dim3(grid), dim3(NTHREADS), LDS_BYTES, stream, a);
    }
#endif
}
```

```cpp
#include <hip/hip_runtime.h>
#include <hip/hip_cooperative_groups.h>
#include <cstdio>
#include <cstdint>
#include <cmath>
namespace cg = cooperative_groups;

#ifndef MK_ONE_LAUNCH
#define MK_ONE_LAUNCH 1
#endif
namespace pg8 {
#define PG8_LAS __attribute__((address_space(3)))
typedef unsigned short bf16_t;
typedef short bf16x8 __attribute__((ext_vector_type(8)));
typedef float f32x4 __attribute__((ext_vector_type(4)));
typedef unsigned u32x4 __attribute__((ext_vector_type(4)));
typedef unsigned u32x2 __attribute__((ext_vector_type(2)));
constexpr int BM = 256, BK = 64, HALF = 128, HTB = HALF * BK * 2  , STAGE_BYTES = 8 * HTB, NXCD = 8, WGM = 8;

__host__ __device__ __forceinline__ int lds_byte(int r, int c) { const int st = (r >> 4) * 2 + (c >> 5), rr = r & 15, cc = c & 31, ob = rr * 64 + cc * 2; return st * 1024 + (ob ^ (((ob >> 9) & 1) << 5)); }
__host__ __device__ __forceinline__ void stage_rc(int b, int& R, int& C) { const int st = b / 1024, sb = b % 1024, swz = sb ^ (((sb >> 9) & 1) << 5); R = (st >> 1) * 16 + swz / 64; C = (st & 1) * 32 + (swz % 64) / 2; }
__host__ __device__ __forceinline__ int perm32(int rho) { const int n = rho >> 4, i = rho & 15; return 8 * (i >> 2) + 4 * n + (i & 3); }

struct Unit { int pm, pn; };
struct Gemm { const bf16_t* A; const bf16_t* Bt; int M, N, K; };

struct StaticOrder {
    int nM, nN, nwg, G, c;
    __host__ __device__ void init(int M, int N, int G_, int c_) { nM = M / BM; nN = N / BM; nwg = nM * nN; G = G_; c = c_; }
    __host__ __device__ bool next(int i, Unit& u) const {
        const long L = (long)i * G + c; if (L >= nwg) return false;
        int wgid = (int)L; { const int q = nwg / NXCD, r = nwg % NXCD, xcd = wgid % NXCD, off = wgid / NXCD; wgid = (xcd < r ? xcd * (q + 1) : r * (q + 1) + (xcd - r) * q) + off; }
        const int nig = WGM * nN, gid = wgid / nig, fm = gid * WGM, gsz = (nM - fm) < WGM ? (nM - fm) : WGM;
        u.pm = fm + ((wgid % nig) % gsz); u.pn = (wgid % nig) / gsz; return true;
    }
    __device__ __forceinline__ void a_ready(const Unit&) const {}
    __device__ __forceinline__ void done(const Unit&) const {}
};

__device__ __forceinline__ unsigned cvt_pk_bf16(float lo, float hi) { unsigned r; asm volatile("v_cvt_pk_bf16_f32 %0, %1, %2" : "=v"(r) : "v"(lo), "v"(hi)); return r; }
typedef float f32x2 __attribute__((ext_vector_type(2)));

__device__ __forceinline__ float bf2f(unsigned short v) { return __uint_as_float(((unsigned)v) << 16); }
__device__ __forceinline__ float bflo(unsigned w) { return __uint_as_float(w << 16); }
__device__ __forceinline__ float bfhi(unsigned w) { return __uint_as_float(w & 0xffff0000u); }
__device__ __forceinline__ float sigmoid_f(float x) { return __builtin_amdgcn_rcpf(1.0f + __builtin_amdgcn_exp2f(-1.4426950408889634f * x)); }

struct EpiSwiglu {
    static constexpr bool PERM = true, AFTER_DRAIN = false, HOOK = false;
    bf16_t* O; int ldc;
    __device__ __forceinline__ void operator()(const f32x4 (&acc)[2][2][4][2], const Unit& u, int wr, int wc, int fr, int fq) const {
        const int row0 = u.pm * BM + wr * 64 + fr, col0 = u.pn * HALF + wc * 32 + 8 * fq;
#pragma unroll
        for (int ai = 0; ai < 2; ++ai)
#pragma unroll
            for (int m = 0; m < 4; ++m) {
                bf16_t* rowp = O + (size_t)(row0 + ai * HALF + m * 16) * ldc + col0;
                float v[8];
#pragma unroll
                for (int n = 0; n < 2; ++n)
#pragma unroll
                    for (int e = 0; e < 4; ++e) { const float g = acc[ai][0][m][n][e], up = acc[ai][1][m][n][e]; v[4 * n + e] = g * sigmoid_f(g) * up; }
                u32x4 w; w.x = cvt_pk_bf16(v[0], v[1]); w.y = cvt_pk_bf16(v[2], v[3]); w.z = cvt_pk_bf16(v[4], v[5]); w.w = cvt_pk_bf16(v[6], v[7]);
                *(u32x4*)rowp = w;
            }
    }
};
struct EpiF32 {
    static constexpr bool PERM = false, AFTER_DRAIN = false, HOOK = false;
    float* O; int ldc;
    __device__ __forceinline__ void operator()(const f32x4 (&acc)[2][2][4][2], const Unit& u, int wr, int wc, int fr, int fq) const {
        const int row0 = u.pm * BM + wr * 64 + fr, col0 = u.pn * BM + wc * 32 + 4 * fq;
#pragma unroll
        for (int ai = 0; ai < 2; ++ai)
#pragma unroll
            for (int m = 0; m < 4; ++m) {
                float* rowp = O + (size_t)(row0 + ai * HALF + m * 16) * ldc + col0;
#pragma unroll
                for (int bj = 0; bj < 2; ++bj)
#pragma unroll
                    for (int n = 0; n < 2; ++n) *(f32x4*)(rowp + bj * HALF + n * 16) = acc[ai][bj][m][n];
            }
    }
};
struct EpiBf16 {
    static constexpr bool PERM = true, AFTER_DRAIN = false, HOOK = false;
    bf16_t* O; int ldc;
    __device__ __forceinline__ void operator()(const f32x4 (&acc)[2][2][4][2], const Unit& u, int wr, int wc, int fr, int fq) const {
        const int row0 = u.pm * BM + wr * 64 + fr, col0 = u.pn * BM + wc * 32 + 8 * fq;
#pragma unroll
        for (int ai = 0; ai < 2; ++ai)
#pragma unroll
            for (int m = 0; m < 4; ++m) {
                bf16_t* rowp = O + (size_t)(row0 + ai * HALF + m * 16) * ldc + col0;
#pragma unroll
                for (int bj = 0; bj < 2; ++bj) {
                    const f32x4 v0 = acc[ai][bj][m][0], v1 = acc[ai][bj][m][1];
                    u32x4 w; w.x = cvt_pk_bf16(v0[0], v0[1]); w.y = cvt_pk_bf16(v0[2], v0[3]); w.z = cvt_pk_bf16(v1[0], v1[1]); w.w = cvt_pk_bf16(v1[2], v1[3]);
                    *(u32x4*)(rowp + bj * HALF) = w;
                }
            }
    }
};
struct EpiProj {
    static constexpr bool PERM = true, AFTER_DRAIN = false, HOOK = false;
    bf16_t* O; int ldc; const float* bgate; float qscale;
    __device__ __forceinline__ void operator()(const f32x4 (&acc)[2][2][4][2], const Unit& u, int wr, int wc, int fr, int fq) const {
        const int row0 = u.pm * BM + wr * 64 + fr;
        if (u.pn >= 11) {
            const int oc = 64 * (u.pn - 11) + 16 * wc + 4 * fq;
            f32x4 bv[4];
#pragma unroll
            for (int k = 0; k < 4; ++k) bv[k] = *(const f32x4*)(bgate + 1024 * k + oc);
#pragma unroll
            for (int ai = 0; ai < 2; ++ai)
#pragma unroll
                for (int m = 0; m < 4; ++m) {
                    bf16_t* rowp = O + (size_t)(row0 + ai * HALF + m * 16) * ldc + 2816 + oc;
                    f32x4 g0 = acc[ai][0][m][0] + bv[0], g1 = acc[ai][0][m][1] + bv[1], g2 = acc[ai][1][m][0] + bv[2], g3 = acc[ai][1][m][1] + bv[3], r1, r2, r3;
#pragma unroll
                    for (int e = 0; e < 4; ++e) {
                        g0[e] = fmaxf(sigmoid_f(g0[e]), 1e-6f); g1[e] = fmaxf(sigmoid_f(g1[e]), 1e-6f); g2[e] = fmaxf(sigmoid_f(g2[e]), 1e-6f); g3[e] = fmaxf(sigmoid_f(g3[e]), 1e-6f);
                        r1[e] = g0[e] * __builtin_amdgcn_rcpf(g1[e]); r2[e] = g1[e] * __builtin_amdgcn_rcpf(g2[e]); r3[e] = g2[e] * __builtin_amdgcn_rcpf(g3[e]);
                    }
                    u32x2 w;
                    w.x = cvt_pk_bf16(r1[0], r1[1]); w.y = cvt_pk_bf16(r1[2], r1[3]); *(u32x2*)(rowp) = w;
                    w.x = cvt_pk_bf16(r2[0], r2[1]); w.y = cvt_pk_bf16(r2[2], r2[3]); *(u32x2*)(rowp + 1024) = w;
                    w.x = cvt_pk_bf16(r3[0], r3[1]); w.y = cvt_pk_bf16(r3[2], r3[3]); *(u32x2*)(rowp + 2048) = w;
                    w.x = cvt_pk_bf16(g3[0], g3[1]); w.y = cvt_pk_bf16(g3[2], g3[3]); *(u32x2*)(rowp + 3072) = w;
                }
        } else {
            const int col0 = u.pn * BM + wc * 32 + 8 * fq;
            const float sc = (u.pn == 0 || u.pn == 8 || u.pn == 9) ? qscale : 1.0f;
#pragma unroll
            for (int ai = 0; ai < 2; ++ai)
#pragma unroll
                for (int m = 0; m < 4; ++m) {
                    bf16_t* rowp = O + (size_t)(row0 + ai * HALF + m * 16) * ldc + col0;
#pragma unroll
                    for (int bj = 0; bj < 2; ++bj) {
                        const f32x4 v0 = acc[ai][bj][m][0] * sc, v1 = acc[ai][bj][m][1] * sc;
                        u32x4 w; w.x = cvt_pk_bf16(v0[0], v0[1]); w.y = cvt_pk_bf16(v0[2], v0[3]); w.z = cvt_pk_bf16(v1[0], v1[1]); w.w = cvt_pk_bf16(v1[2], v1[3]);
                        *(u32x4*)(rowp + bj * HALF) = w;
                    }
                }
        }
    }
};
struct EpiMerge {
    static constexpr bool PERM = true, AFTER_DRAIN = false, HOOK = true;
    bf16_t* O; int ldc; const bf16_t* G; int ldg;
    __device__ __forceinline__ void hook(f32x4 (&acc)[2][2][4][2], const Unit& u, int br, int wr, int wc, int fr, int fq) const {
        const int row0 = u.pm * BM + wr * 64 + fr, col0 = u.pn * BM + wc * 32 + 8 * fq;
        u32x4 rr[2][4][2];
#pragma unroll
        for (int ai = 0; ai < 2; ++ai)
#pragma unroll
            for (int m = 0; m < 4; ++m) {
                const bf16_t* gp = G + (size_t)(row0 + ai * HALF + m * 16) * ldg + col0 + 1024 * (br - 1);
#pragma unroll
                for (int bj = 0; bj < 2; ++bj) rr[ai][m][bj] = __builtin_nontemporal_load((const u32x4*)(gp + bj * HALF));
            }
#pragma unroll
        for (int ai = 0; ai < 2; ++ai)
#pragma unroll
            for (int m = 0; m < 4; ++m)
#pragma unroll
                for (int bj = 0; bj < 2; ++bj) {
                    const u32x4 q = rr[ai][m][bj];
                    acc[ai][bj][m][0] = acc[ai][bj][m][0] * (f32x4){bflo(q.x), bfhi(q.x), bflo(q.y), bfhi(q.y)};
                    acc[ai][bj][m][1] = acc[ai][bj][m][1] * (f32x4){bflo(q.z), bfhi(q.z), bflo(q.w), bfhi(q.w)};
                }
        asm volatile("" ::: "memory");
    }
    __device__ __forceinline__ void operator()(const f32x4 (&acc)[2][2][4][2], const Unit& u, int wr, int wc, int fr, int fq) const {
        const int row0 = u.pm * BM + wr * 64 + fr, col0 = u.pn * BM + wc * 32 + 8 * fq;
#pragma unroll
        for (int ai = 0; ai < 2; ++ai) {
            u32x4 gc[4][2];
#pragma unroll
            for (int m = 0; m < 4; ++m)
#pragma unroll
                for (int bj = 0; bj < 2; ++bj) gc[m][bj] = *(const u32x4*)(G + (size_t)(row0 + ai * HALF + m * 16) * ldg + col0 + 3072 + bj * HALF);
#pragma unroll
            for (int m = 0; m < 4; ++m) {
                bf16_t* rowp = O + (size_t)(row0 + ai * HALF + m * 16) * ldc + col0;
#pragma unroll
                for (int bj = 0; bj < 2; ++bj) {
                    const u32x4 c = gc[m][bj];
                    const f32x4 a0 = acc[ai][bj][m][0], a1 = acc[ai][bj][m][1];
                    u32x4 w; w.x = cvt_pk_bf16(a0[0] * bflo(c.x), a0[1] * bfhi(c.x)); w.y = cvt_pk_bf16(a0[2] * bflo(c.y), a0[3] * bfhi(c.y));
                    w.z = cvt_pk_bf16(a1[0] * bflo(c.z), a1[1] * bfhi(c.z)); w.w = cvt_pk_bf16(a1[2] * bflo(c.w), a1[3] * bfhi(c.w));
                    *(u32x4*)(rowp + bj * HALF) = w;
                }
            }
            asm volatile("" ::: "memory");
        }
    }
};
template <class Epi, class Sched, bool ALIGN_EPI = false, bool SP2 = false>
__device__ __forceinline__ void gemm_phase(PG8_LAS unsigned char* lds, const Gemm g, const Sched& S, const Epi& E) {
    int tid_ = threadIdx.x; asm volatile("" : "+v"(tid_));
    const int tid = tid_, wid = __builtin_amdgcn_readfirstlane(tid >> 6), lane = tid & 63, wr = wid >> 2, wc = wid & 3, fr = lane & 15, fq = lane >> 4;
    const int K = g.K, nt = K / BK;
    unsigned voffA[2], voffB[2];
#pragma unroll
    for (int i = 0; i < 2; ++i) { int R, C; stage_rc(tid * 16 + i * 8192, R, C); const int Rb = Epi::PERM ? ((R & ~31) + perm32(R & 31)) : R;
        voffA[i] = (unsigned)(R * K + C) * 2u; voffB[i] = (unsigned)(Rb * K + C) * 2u; }
    const size_t kstep = (size_t)(BK * 2);
    const size_t hstep = (size_t)HALF * K * 2;
    const size_t tstep = 2 * hstep;
    const unsigned ldsw = (unsigned)wid * 1024u;
    const int aoff = lds_byte(wr * 64 + fr, fq * 8), boff = lds_byte(wc * 32 + fr, fq * 8);
#define PG8_SA(b, h) (((b) * 2 + (h)) * HTB)
#define PG8_SB(b, h) ((4 + (b) * 2 + (h)) * HTB)
#define PG8_STAGE(bufoff, gbase, voff) do { _Pragma("unroll") for (int _i = 0; _i < 2; ++_i) \
        __builtin_amdgcn_global_load_lds((const unsigned*)((const char*)(gbase) + (voff)[_i]), (PG8_LAS unsigned*)(lds + (bufoff) + ldsw + _i * 8192), 16, 0, 0); } while (0)
#define PG8_LDA(dst, b, h) do { _Pragma("unroll") for (int m = 0; m < 4; ++m) _Pragma("unroll") for (int k = 0; k < 2; ++k) dst[m][k] = *(const PG8_LAS bf16x8*)(lds + PG8_SA(b, h) + aoff + m * 2048 + k * 1024); } while (0)
#define PG8_LDB(dst, b, h) do { _Pragma("unroll") for (int n = 0; n < 2; ++n) _Pragma("unroll") for (int k = 0; k < 2; ++k) dst[n][k] = *(const PG8_LAS bf16x8*)(lds + PG8_SB(b, h) + boff + n * 2048 + k * 1024); } while (0)
#define PG8_MMA(ai, bj, At, Bt) do { __builtin_amdgcn_s_setprio(1); _Pragma("unroll") for (int m = 0; m < 4; ++m) _Pragma("unroll") for (int n = 0; n < 2; ++n) _Pragma("unroll") for (int k = 0; k < 2; ++k) \
        acc[ai][bj][m][n] = __builtin_amdgcn_mfma_f32_16x16x32_bf16(Bt[n][k], At[m][k], acc[ai][bj][m][n], 0, 0, 0); __builtin_amdgcn_s_setprio(0); } while (0)
#define PG8_WAIT_V(n) asm volatile("s_waitcnt vmcnt(" #n ")" ::: "memory")
#define PG8_WAIT_L(n) asm volatile("s_waitcnt lgkmcnt(" #n ")" ::: "memory")
#define PG8_BAR __builtin_amdgcn_s_barrier()
#define PG8_SCHED __builtin_amdgcn_sched_barrier(0)
    Unit cur, nxt; int ui = 0;
    if (!S.next(0, cur)) return;
    f32x4 acc[2][2][4][2];
#pragma unroll
    for (int a = 0; a < 2; ++a)
#pragma unroll
        for (int b = 0; b < 2; ++b)
#pragma unroll
            for (int m = 0; m < 4; ++m)
#pragma unroll
                for (int n = 0; n < 2; ++n) acc[a][b][m][n] = (f32x4){0.f, 0.f, 0.f, 0.f};
    bf16x8 At[4][2], B0[2][2], B1[2][2];
    const char* cA = (const char*)g.A + (size_t)cur.pm * tstep; const char* cB = (const char*)g.Bt + (size_t)cur.pn * tstep;
    S.a_ready(cur);
    if constexpr (SP2) {
        PG8_STAGE(PG8_SB(0, 0), cB, voffB); PG8_STAGE(PG8_SB(0, 1), cB + hstep, voffB); PG8_STAGE(PG8_SA(0, 0), cA, voffA); PG8_STAGE(PG8_SA(0, 1), cA + hstep, voffA);
        if (wr == 1) PG8_BAR;
        PG8_WAIT_V(2); PG8_BAR;
        PG8_STAGE(PG8_SB(1, 0), cB + kstep, voffB); PG8_STAGE(PG8_SA(1, 0), cA + kstep, voffA); PG8_STAGE(PG8_SB(1, 1), cB + hstep + kstep, voffB);
        PG8_WAIT_V(6); PG8_BAR;
    } else {
        PG8_STAGE(PG8_SB(0, 0), cB, voffB); PG8_STAGE(PG8_SA(0, 0), cA, voffA); PG8_STAGE(PG8_SB(0, 1), cB + hstep, voffB); PG8_STAGE(PG8_SA(0, 1), cA + hstep, voffA);
        if (wr == 1) PG8_BAR;
        PG8_WAIT_V(4); PG8_BAR;
        PG8_STAGE(PG8_SB(1, 0), cB + kstep, voffB); PG8_STAGE(PG8_SA(1, 0), cA + kstep, voffA); PG8_STAGE(PG8_SB(1, 1), cB + hstep + kstep, voffB);
        PG8_WAIT_V(6); PG8_BAR;
    }
    for (;;) {
        const bool has_next = S.next(ui + 1, nxt);
        const char* nA = has_next ? (const char*)g.A + (size_t)nxt.pm * tstep : cA; const char* nB = has_next ? (const char*)g.Bt + (size_t)nxt.pn * tstep : cB;
        for (int t = 0; t < nt; t += 2) {
            if constexpr (Epi::HOOK) { if (t == 4 || t == 8 || t == 12) E.hook(acc, cur, t >> 2, wr, wc, fr, fq); }
            const bool last = (t == nt - 2);
            const char* a1 = cA + (size_t)(t + 1) * kstep;
            const char* a2 = last ? nA : cA + (size_t)(t + 2) * kstep; const char* b2 = last ? nB : cB + (size_t)(t + 2) * kstep;
            const char* a3 = a2 + kstep; const char* b3 = b2 + kstep;
            if (last && has_next) S.a_ready(nxt);
            if constexpr (SP2) {
            PG8_LDB(B0, 0, 0); PG8_LDB(B1, 0, 1); PG8_SCHED; PG8_LDA(At, 0, 0); PG8_STAGE(PG8_SA(1, 1), a1 + hstep, voffA);
            PG8_WAIT_V(8); PG8_WAIT_L(0); PG8_BAR; PG8_MMA(0, 0, At, B0); PG8_MMA(0, 1, At, B1); PG8_BAR; PG8_SCHED;
            PG8_LDA(At, 0, 1); PG8_STAGE(PG8_SB(0, 0), b2, voffB); PG8_STAGE(PG8_SB(0, 1), b2 + hstep, voffB); PG8_STAGE(PG8_SA(0, 0), a2, voffA);
            PG8_WAIT_V(8); PG8_WAIT_L(0); PG8_BAR; PG8_MMA(1, 0, At, B0); PG8_MMA(1, 1, At, B1); PG8_BAR; PG8_SCHED;
            PG8_LDB(B0, 1, 0); PG8_LDB(B1, 1, 1); PG8_SCHED; PG8_LDA(At, 1, 0); PG8_STAGE(PG8_SA(0, 1), a2 + hstep, voffA);
            PG8_WAIT_V(8); PG8_WAIT_L(0); PG8_BAR; PG8_MMA(0, 0, At, B0); PG8_MMA(0, 1, At, B1); PG8_BAR; PG8_SCHED;
            PG8_LDA(At, 1, 1); PG8_STAGE(PG8_SB(1, 0), b3, voffB); PG8_STAGE(PG8_SB(1, 1), b3 + hstep, voffB); PG8_STAGE(PG8_SA(1, 0), a3, voffA);
            PG8_WAIT_V(8); PG8_WAIT_L(0); PG8_BAR; PG8_MMA(1, 0, At, B0); PG8_MMA(1, 1, At, B1); PG8_BAR; PG8_SCHED;
            } else {
            PG8_LDB(B0, 0, 0); PG8_SCHED; PG8_LDA(At, 0, 0); PG8_STAGE(PG8_SA(1, 1), a1 + hstep, voffA);
            PG8_WAIT_L(8); PG8_BAR; PG8_WAIT_L(0); PG8_MMA(0, 0, At, B0); PG8_BAR; PG8_SCHED;
            PG8_LDB(B1, 0, 1); PG8_STAGE(PG8_SB(0, 0), b2, voffB);
            PG8_BAR; PG8_WAIT_L(0); PG8_MMA(0, 1, At, B1); PG8_BAR;
            PG8_LDA(At, 0, 1); PG8_STAGE(PG8_SA(0, 0), a2, voffA);
            PG8_BAR; PG8_WAIT_L(0); PG8_MMA(1, 0, At, B0); PG8_BAR; PG8_SCHED;
            PG8_STAGE(PG8_SB(0, 1), b2 + hstep, voffB);
            PG8_WAIT_V(6); PG8_BAR; PG8_MMA(1, 1, At, B1); PG8_BAR;
            PG8_LDB(B0, 1, 0); PG8_SCHED; PG8_LDA(At, 1, 0); PG8_STAGE(PG8_SA(0, 1), a2 + hstep, voffA);
            PG8_WAIT_L(8); PG8_BAR; PG8_WAIT_L(0); PG8_MMA(0, 0, At, B0); PG8_BAR; PG8_SCHED;
            PG8_LDB(B1, 1, 1); PG8_STAGE(PG8_SB(1, 0), b3, voffB);
            PG8_BAR; PG8_WAIT_L(0); PG8_MMA(0, 1, At, B1); PG8_BAR;
            PG8_LDA(At, 1, 1); PG8_STAGE(PG8_SA(1, 0), a3, voffA);
            PG8_BAR; PG8_WAIT_L(0); PG8_MMA(1, 0, At, B0); PG8_BAR; PG8_SCHED;
            PG8_STAGE(PG8_SB(1, 1), b3 + hstep, voffB);
            PG8_WAIT_V(6); PG8_BAR; PG8_MMA(1, 1, At, B1); PG8_BAR;
            }
        }
        if constexpr (ALIGN_EPI) { if (wr == 0) PG8_BAR; }
        if constexpr (!Epi::AFTER_DRAIN) { E(acc, cur, wr, wc, fr, fq); S.done(cur); }
        if (!has_next) break;
#pragma unroll
        for (int a = 0; a < 2; ++a)
#pragma unroll
            for (int b = 0; b < 2; ++b)
#pragma unroll
                for (int m = 0; m < 4; ++m)
#pragma unroll
                    for (int n = 0; n < 2; ++n) acc[a][b][m][n] = (f32x4){0.f, 0.f, 0.f, 0.f};
        cur = nxt; cA = nA; cB = nB; ++ui;
        if constexpr (ALIGN_EPI) { if (wr == 1) PG8_BAR; }
    }
    PG8_WAIT_V(0);
    if constexpr (!ALIGN_EPI) { if (wr == 0) PG8_BAR; }
    PG8_BAR;
    if constexpr (Epi::AFTER_DRAIN) { E.fused(acc, cur, wr, wc, fr, fq, lds, wid, lane); S.done(cur); }
#undef PG8_SA
#undef PG8_SB
#undef PG8_STAGE
#undef PG8_LDA
#undef PG8_LDB
#undef PG8_MMA
#undef PG8_WAIT_V
#undef PG8_WAIT_L
#undef PG8_BAR
#undef PG8_SCHED
}
}

#define LAS __attribute__((address_space(3)))
typedef unsigned short bf16_t;
typedef short bf16x8 __attribute__((ext_vector_type(8)));
typedef float f32x4 __attribute__((ext_vector_type(4)));
typedef float f32x16 __attribute__((ext_vector_type(16)));
typedef unsigned u32x4 __attribute__((ext_vector_type(4)));
typedef unsigned u32x2 __attribute__((ext_vector_type(2)));
using pg8::bflo; using pg8::bfhi; using pg8::sigmoid_f; using pg8::cvt_pk_bf16;

constexpr int DM = 1024, NB = 32, SEQ = 2048, DEPTH = 4, M = NB * SEQ, FF = 2816, NIN = 6916, NPROJ = 6912, PLE = 256, YW = 1280;
constexpr int MH = M / 2;
constexpr float EPS = 1e-6f, LOG2E = 1.4426950408889634f, QSCALE = 0.125f * 1.4426950408889634f, NEGBIG = -1e30f;
constexpr int NWAVES = 8, NTHREADS = 512;
constexpr int LDS_BYTES = 147456;
constexpr int PH_PER_LAYER = 17, N_PHASES = PH_PER_LAYER * DEPTH;

constexpr size_t MiB = 1u << 20;
constexpr size_t WS_W = 1 * MiB, WS_CTL_BAR = 16384, CTL_ZERO_BYTES = 65536;
constexpr size_t W_GU1 = WS_W, W_D1 = W_GU1 + (size_t)2 * FF * DM * 2, W_IN = W_D1 + (size_t)DM * FF * 2, W_BR = W_IN + (size_t)NPROJ * DM * 2, W_O = W_BR + (size_t)DM * YW * 2,
                 W_GU2 = W_O + (size_t)DM * DM * 2, W_D2 = W_GU2 + (size_t)2 * FF * DM * 2, W_PG = W_D2 + (size_t)DM * FF * 2, W_PLE = W_PG + (size_t)DM * DM * 2, W_AF = W_PLE + (size_t)DM * PLE * 2, W_END = W_AF + 16384;
static_assert(W_END <= 58 * MiB, "weights region");
constexpr size_t WS_U = 64 * MiB, WS_HID = 192 * MiB, WS_F = 544 * MiB, WS_PROJ = 192 * MiB, WS_YCAT = 624 * MiB, WS_MERGED = 800 * MiB, WS_LOGF = 928 * MiB, WS_CUM = 929 * MiB, WS_PBF = 930 * MiB, WS_F2 = 192 * MiB, WS_WB = 962 * MiB, WS_NEED = 1020 * MiB;
static_assert(WS_PROJ + (size_t)MH * NPROJ * 2 <= WS_YCAT && WS_YCAT + (size_t)M * YW * 2 <= WS_MERGED && WS_MERGED + (size_t)M * DM * 2 <= WS_LOGF && WS_HID + (size_t)M * FF * 2 <= WS_F && WS_F + (size_t)M * DM * 4 <= WS_MERGED && WS_PBF + (size_t)M * PLE * 2 <= WS_NEED && WS_F2 + (size_t)M * DM * 4 <= WS_F, "ws map");

#define CAS __attribute__((address_space(4)))
struct Args { const float* in[31]; float* out; unsigned char* ws; int ph_lo, ph_hi; unsigned char bucket[128]; };

template <int CTRL> __device__ __forceinline__ float dpp_f(float v) { return __builtin_bit_cast(float, __builtin_amdgcn_update_dpp(0, __builtin_bit_cast(int, v), CTRL, 0xf, 0xf, false)); }
__device__ __forceinline__ float wave_sum(float v) {
    v += dpp_f<0xB1>(v);
    v += dpp_f<0x4E>(v);
    v += dpp_f<0x141>(v);
    v += dpp_f<0x140>(v);
    const int b = __builtin_bit_cast(int, v);
    const float r0 = __builtin_bit_cast(float, __builtin_amdgcn_readlane(b, 0)), r1 = __builtin_bit_cast(float, __builtin_amdgcn_readlane(b, 16));
    const float r2 = __builtin_bit_cast(float, __builtin_amdgcn_readlane(b, 32)), r3 = __builtin_bit_cast(float, __builtin_amdgcn_readlane(b, 48));
    return (r0 + r1) + (r2 + r3);
}
__device__ __forceinline__ unsigned f2bf(float f) { unsigned u = __builtin_bit_cast(unsigned, f); return (u + 0x7fffu + ((u >> 16) & 1u)) >> 16; }
__device__ __forceinline__ unsigned pk2(float lo, float hi) { return f2bf(lo) | (f2bf(hi) << 16); }

__device__ __forceinline__ void transpose_item(const float* W, int ldn, int k0, int srccol4, bf16_t* WT, int ldk, int dst_row0, int dst_k0, LAS float* scr, int lane) {
    const int grp = lane & 7, kq = lane >> 3;
    f32x4 v[8];
#pragma unroll
    for (int i = 0; i < 8; ++i) v[i] = *(const f32x4*)(W + (size_t)(k0 + kq + 8 * i) * ldn + srccol4);
#pragma unroll
    for (int i = 0; i < 8; ++i) { LAS float* d = scr + (kq + 8 * i) * 33 + 4 * grp; d[0] = v[i][0]; d[1] = v[i][1]; d[2] = v[i][2]; d[3] = v[i][3]; }
    asm volatile("s_waitcnt lgkmcnt(0)" ::: "memory");
    const int c = lane & 7;
#pragma unroll
    for (int j = 0; j < 4; ++j) { const int n = (lane >> 3) + 8 * j; const LAS float* s = scr + (8 * c) * 33 + n;
        u32x4 o; o.x = pk2(s[0 * 33], s[1 * 33]); o.y = pk2(s[2 * 33], s[3 * 33]); o.z = pk2(s[4 * 33], s[5 * 33]); o.w = pk2(s[6 * 33], s[7 * 33]);
        *(u32x4*)(WT + (size_t)(dst_row0 + n) * ldk + dst_k0 + 8 * c) = o; }
    asm volatile("s_waitcnt lgkmcnt(0)" ::: "memory");
}
__device__ __forceinline__ void transpose_matrix_item(const float* W, int K, int ldn, int Ndst, int mode, bf16_t* WT, int ldk, int dst_k0, LAS float* scr, int item, int lane) {
    const int nnb = Ndst / 32, kb = item / nnb, nb = item % nnb, n0 = nb * 32;
    const int j = 4 * (lane & 7); int src;
    if (mode == 1) { const int t = n0 >> 8, r = n0 & 255; src = ((r < 128) ? (128 * t + r) : (FF + 128 * t + (r - 128))) + j; }
    else if (mode == 2) {
        if (n0 < 2816) src = n0 + (n0 >= 768 ? 4 : 0) + j;
        else {
            const int gl = n0 - 2816, T = gl >> 8, l0 = gl & 255, bj = l0 >> 7, wc = (l0 >> 5) & 3, fq = j >> 3, n = (j >> 2) & 1;
            src = 2820 + 1024 * (2 * bj + n) + 64 * T + 16 * wc + 4 * fq;
        }
    }
    else src = n0 + j;
    transpose_item(W, ldn, kb * 64, src, WT, ldk, n0, dst_k0 + kb * 64, scr, lane);
}
__device__ __forceinline__ void wconv_phase(const CAS Args* a, int L, int part, LAS unsigned char* lds, int gw, int NGW, int wave, int lane) {
    LAS float* scr = (LAS float*)(lds + wave * 16384);
    unsigned char* ws = a->ws + ((L & 1) ? WS_WB - WS_W : 0);
    const float* gu1 = a->in[3] + (size_t)L * DM * 2 * FF; const float* d1 = a->in[4] + (size_t)L * FF * DM; const float* win = a->in[7] + (size_t)L * DM * NIN;
    const float* bra = a->in[17] + (size_t)L * 256 * DM; const float* brb = a->in[18] + (size_t)L * 256 * DM; const float* brc = a->in[19] + (size_t)L * 256 * DM; const float* brd = a->in[20] + (size_t)L * 512 * DM;
    const float* wo = a->in[21] + (size_t)L * DM * DM; const float* gu2 = a->in[24] + (size_t)L * DM * 2 * FF; const float* d2 = a->in[25] + (size_t)L * FF * DM;
    const float* wpg = a->in[28] + (size_t)L * DM * DM; const float* wple = a->in[29] + (size_t)L * PLE * DM;
    constexpr int I_GU = (DM / 64) * (2 * FF / 32), I_D = (FF / 64) * (DM / 32), I_IN = (DM / 64) * (NPROJ / 32), I_BR = (256 / 64) * (DM / 32), I_BRD = (512 / 64) * (DM / 32), I_SQ = (DM / 64) * (DM / 32), I_PLE = (PLE / 64) * (DM / 32);
    constexpr int NITEMS = 2 * I_GU + 2 * I_D + I_IN + 3 * I_BR + I_BRD + 2 * I_SQ + I_PLE;
    const int it_lo = (part == 1) ? NITEMS / 2 : 0, it_hi = (part == 0) ? NITEMS / 2 : NITEMS;
    for (int it = it_lo + gw; it < it_hi; it += NGW) {
        int r = it;
        if (r < I_GU) { transpose_matrix_item(gu1, DM, 2 * FF, 2 * FF, 1, (bf16_t*)(ws + W_GU1), DM, 0, scr, r, lane); continue; } r -= I_GU;
        if (r < I_GU) { transpose_matrix_item(gu2, DM, 2 * FF, 2 * FF, 1, (bf16_t*)(ws + W_GU2), DM, 0, scr, r, lane); continue; } r -= I_GU;
        if (r < I_D) { transpose_matrix_item(d1, FF, DM, DM, 0, (bf16_t*)(ws + W_D1), FF, 0, scr, r, lane); continue; } r -= I_D;
        if (r < I_D) { transpose_matrix_item(d2, FF, DM, DM, 0, (bf16_t*)(ws + W_D2), FF, 0, scr, r, lane); continue; } r -= I_D;
        if (r < I_IN) { transpose_matrix_item(win, DM, NIN, NPROJ, 2, (bf16_t*)(ws + W_IN), DM, 0, scr, r, lane); continue; } r -= I_IN;
        if (r < I_BR) { transpose_matrix_item(bra, 256, DM, DM, 0, (bf16_t*)(ws + W_BR), YW, 0, scr, r, lane); continue; } r -= I_BR;
        if (r < I_BR) { transpose_matrix_item(brb, 256, DM, DM, 0, (bf16_t*)(ws + W_BR), YW, 256, scr, r, lane); continue; } r -= I_BR;
        if (r < I_BR) { transpose_matrix_item(brc, 256, DM, DM, 0, (bf16_t*)(ws + W_BR), YW, 512, scr, r, lane); continue; } r -= I_BR;
        if (r < I_BRD) { transpose_matrix_item(brd, 512, DM, DM, 0, (bf16_t*)(ws + W_BR), YW, 768, scr, r, lane); continue; } r -= I_BRD;
        if (r < I_SQ) { transpose_matrix_item(wo, DM, DM, DM, 0, (bf16_t*)(ws + W_O), DM, 0, scr, r, lane); continue; } r -= I_SQ;
        if (r < I_SQ) { transpose_matrix_item(wpg, DM, DM, DM, 0, (bf16_t*)(ws + W_PG), DM, 0, scr, r, lane); continue; } r -= I_SQ;
        transpose_matrix_item(wple, PLE, DM, DM, 0, (bf16_t*)(ws + W_PLE), PLE, 0, scr, r, lane);
    }
    float* af = (float*)(ws + W_AF);
    if (part != 1) for (int i = gw * 64 + lane; i < DM * 4; i += NGW * 64) af[i] = win[(size_t)(i >> 2) * NIN + 768 + (i & 3)];
}

__device__ __forceinline__ float log_sigmoid_f(float x) { return fminf(x, 0.f) - log1pf(expf(-fabsf(x))); }
typedef _Float16 h16x2 __attribute__((ext_vector_type(2)));
__device__ __forceinline__ unsigned pkh(float a, float b) { h16x2 v; v.x = (_Float16)a; v.y = (_Float16)b; return __builtin_bit_cast(unsigned, v); }
__device__ __forceinline__ float hlo(unsigned w) { return (float)__builtin_bit_cast(h16x2, w).x; }
__device__ __forceinline__ float hhi(unsigned w) { return (float)__builtin_bit_cast(h16x2, w).y; }
struct RowArgs { const float* hin32; const unsigned short* hin16; float* hout32; unsigned short* hout16; const bf16_t* F; const bf16_t* F2; const float* gpost; float scale; const float* gnext; bf16_t* U; const float* AF; const float* bforget; float* LOGF; const float* p; bf16_t* Pbf; };
struct RowRaw { f32x4 v32[2][2]; u32x4 v16[2]; u32x4 f[2]; u32x4 e[2]; f32x4 p; };
__device__ __forceinline__ void row_load(const RowArgs& R, int m, int lane, RowRaw& q) {
    const size_t off = (size_t)m * DM + 8 * lane;
    if (R.hin32) {
#pragma unroll
        for (int j = 0; j < 2; ++j) { q.v32[j][0] = __builtin_nontemporal_load((const f32x4*)(R.hin32 + off + 512 * j)); q.v32[j][1] = __builtin_nontemporal_load((const f32x4*)(R.hin32 + off + 512 * j + 4)); }
    } else {
#pragma unroll
        for (int j = 0; j < 2; ++j) q.v16[j] = __builtin_nontemporal_load((const u32x4*)(R.hin16 + off + 512 * j));
    }
    if (R.F) {
#pragma unroll
        for (int j = 0; j < 2; ++j) q.f[j] = __builtin_nontemporal_load((const u32x4*)(R.F + off + 512 * j));
    }
    if (R.F2) {
#pragma unroll
        for (int j = 0; j < 2; ++j) q.e[j] = __builtin_nontemporal_load((const u32x4*)(R.F2 + off + 512 * j));
    }
    if (R.p) q.p = __builtin_nontemporal_load((const f32x4*)(R.p + (size_t)m * PLE + 4 * lane));
}
#define UNPK_BF(dst, SRC_) do { const u32x4 t_ = (SRC_); dst[0] = bflo(t_.x); dst[1] = bfhi(t_.x); dst[2] = bflo(t_.y); dst[3] = bfhi(t_.y); dst[4] = bflo(t_.z); dst[5] = bfhi(t_.z); dst[6] = bflo(t_.w); dst[7] = bfhi(t_.w); } while (0)
__device__ __forceinline__ void row_process(const RowArgs& R, int m, int lane, const RowRaw& q, const float (&gp)[2][8], const float (&gn)[2][8], const f32x4 bf) {
    const size_t off = (size_t)m * DM + 8 * lane;
    float v[2][8];
    if (R.hin32) {
#pragma unroll
        for (int j = 0; j < 2; ++j)
#pragma unroll
            for (int e = 0; e < 4; ++e) { v[j][e] = q.v32[j][0][e]; v[j][4 + e] = q.v32[j][1][e]; }
    } else {
#pragma unroll
        for (int j = 0; j < 2; ++j) { const u32x4 w = q.v16[j]; v[j][0] = hlo(w.x); v[j][1] = hhi(w.x); v[j][2] = hlo(w.y); v[j][3] = hhi(w.y); v[j][4] = hlo(w.z); v[j][5] = hhi(w.z); v[j][6] = hlo(w.w); v[j][7] = hhi(w.w); }
    }
    if (R.F) {
        float f[2][8];
#pragma unroll
        for (int j = 0; j < 2; ++j) UNPK_BF(f[j], q.f[j]);
        if (R.F2) {
            float e[2][8]; float ss = 0.f;
#pragma unroll
            for (int j = 0; j < 2; ++j) { UNPK_BF(e[j], q.e[j]);
#pragma unroll
                for (int c = 0; c < 8; ++c) ss += e[j][c] * e[j][c]; }
            const float r = 1.0f / sqrtf(wave_sum(ss) * (1.0f / DM) + EPS);
#pragma unroll
            for (int j = 0; j < 2; ++j)
#pragma unroll
                for (int c = 0; c < 8; ++c) v[j][c] += (1.0f / (1.0f + expf(-f[j][c]))) * (e[j][c] * r * gp[j][c]);
        } else {
            float ss = 0.f;
#pragma unroll
            for (int j = 0; j < 2; ++j)
#pragma unroll
                for (int c = 0; c < 8; ++c) ss += f[j][c] * f[j][c];
            const float r = 1.0f / sqrtf(wave_sum(ss) * (1.0f / DM) + EPS);
#pragma unroll
            for (int j = 0; j < 2; ++j)
#pragma unroll
                for (int c = 0; c < 8; ++c) v[j][c] += R.scale * ((f[j][c] * r) * gp[j][c]);
        }
        if (R.hout32) {
#pragma unroll
            for (int j = 0; j < 2; ++j) { __builtin_nontemporal_store((f32x4){v[j][0], v[j][1], v[j][2], v[j][3]}, (f32x4*)(R.hout32 + off + 512 * j)); __builtin_nontemporal_store((f32x4){v[j][4], v[j][5], v[j][6], v[j][7]}, (f32x4*)(R.hout32 + off + 512 * j + 4)); }
        } else {
#pragma unroll
            for (int j = 0; j < 2; ++j) {
                u32x4 w; w.x = pkh(v[j][0], v[j][1]); w.y = pkh(v[j][2], v[j][3]); w.z = pkh(v[j][4], v[j][5]); w.w = pkh(v[j][6], v[j][7]);
                __builtin_nontemporal_store(w, (u32x4*)(R.hout16 + off + 512 * j));
                v[j][0] = hlo(w.x); v[j][1] = hhi(w.x); v[j][2] = hlo(w.y); v[j][3] = hhi(w.y); v[j][4] = hlo(w.z); v[j][5] = hhi(w.z); v[j][6] = hlo(w.w); v[j][7] = hhi(w.w);
            }
        }
    }
    if (R.gnext) {
        float ss = 0.f;
#pragma unroll
        for (int j = 0; j < 2; ++j)
#pragma unroll
            for (int c = 0; c < 8; ++c) ss += v[j][c] * v[j][c];
        const float r2 = 1.0f / sqrtf(wave_sum(ss) * (1.0f / DM) + EPS);
        float un[2][8];
#pragma unroll
        for (int j = 0; j < 2; ++j) {
#pragma unroll
            for (int c = 0; c < 8; ++c) un[j][c] = (v[j][c] * r2) * gn[j][c];
            u32x4 w; w.x = pk2(un[j][0], un[j][1]); w.y = pk2(un[j][2], un[j][3]); w.z = pk2(un[j][4], un[j][5]); w.w = pk2(un[j][6], un[j][7]);
            *(u32x4*)(R.U + off + 512 * j) = w;
        }
        if (R.AF) {
            f32x4 acc = {0.f, 0.f, 0.f, 0.f};
#pragma unroll
            for (int j = 0; j < 2; ++j)
#pragma unroll
                for (int c = 0; c < 8; ++c) acc = acc + un[j][c] * *(const f32x4*)(R.AF + (size_t)(8 * lane + 512 * j + c) * 4);
            acc[0] = wave_sum(acc[0]); acc[1] = wave_sum(acc[1]); acc[2] = wave_sum(acc[2]); acc[3] = wave_sum(acc[3]);
            if (lane == 0) { f32x4 o; o[0] = log_sigmoid_f(acc[0] + bf[0]); o[1] = log_sigmoid_f(acc[1] + bf[1]); o[2] = log_sigmoid_f(acc[2] + bf[2]); o[3] = log_sigmoid_f(acc[3] + bf[3]); *(f32x4*)(R.LOGF + (size_t)m * 4) = o; }
        }
    }
    if (R.p) { u32x2 w; w.x = pk2(q.p[0], q.p[1]); w.y = pk2(q.p[2], q.p[3]); *(u32x2*)(R.Pbf + (size_t)m * PLE + 4 * lane) = w; }
}
__device__ __forceinline__ void row_pass(const RowArgs& R, int gw, int NGW, int lane) {
    float gp[2][8], gn[2][8];
#pragma unroll
    for (int j = 0; j < 2; ++j)
#pragma unroll
        for (int h = 0; h < 2; ++h) {
            const f32x4 a = R.gpost ? *(const f32x4*)(R.gpost + 8 * lane + 512 * j + 4 * h) : (f32x4){0.f, 0.f, 0.f, 0.f};
            const f32x4 b = R.gnext ? *(const f32x4*)(R.gnext + 8 * lane + 512 * j + 4 * h) : (f32x4){0.f, 0.f, 0.f, 0.f};
#pragma unroll
            for (int e = 0; e < 4; ++e) { gp[j][4 * h + e] = a[e]; gn[j][4 * h + e] = b[e]; }
        }
    const f32x4 bf = R.AF ? *(const f32x4*)R.bforget : (f32x4){0.f, 0.f, 0.f, 0.f};
    RowRaw qa, qb;
    if (gw < M) row_load(R, gw, lane, qa);
    for (int m = gw; m < M; m += 2 * NGW) {
        const int m1 = m + NGW, m2 = m + 2 * NGW;
        if (m1 < M) row_load(R, m1, lane, qb);
        row_process(R, m, lane, qa, gp, gn, bf);
        if (m2 < M) row_load(R, m2, lane, qa);
        if (m1 < M) row_process(R, m1, lane, qb, gp, gn, bf);
    }
}
__device__ __forceinline__ void cumsum_seq(const float* LOGF, float* CUM, int seq, int lane) {
    const int b = seq >> 2, h = seq & 3; const size_t base = ((size_t)b * SEQ + 32 * lane) * 4 + h;
    float s = 0.f;
#pragma unroll 8
    for (int i = 0; i < 32; ++i) s += LOGF[base + 4 * i];
    float incl = s;
#pragma unroll
    for (int o = 1; o < 64; o <<= 1) { const float n = __shfl_up(incl, o); if (lane >= o) incl += n; }
    float run = incl - s;
#pragma unroll 8
    for (int i = 0; i < 32; ++i) { run += LOGF[base + 4 * i]; CUM[base + 4 * i] = run * LOG2E; }
}

__device__ __forceinline__ int crow(int r, int hi) { return (r & 3) + 8 * (r >> 2) + 4 * hi; }
__device__ __forceinline__ int kvperm(int kv) { return (kv & 0x33) | (((kv >> 2) & 1) << 3) | (((kv >> 3) & 1) << 2); }
constexpr int KROW = 144;
constexpr float ATT_THR = 8.0f;
template <int TYPE>
__device__ __forceinline__ void attn_tile(f32x16 (&o)[2], float& m, float& l, const bf16x8 (&qr)[4], const LAS unsigned char* Kt, const LAS unsigned char* VTt, int vt_stride,
                                          int kv0, int qpos, float cq, const LAS float* ckv, const LAS float* biasT, bool domask, bool first, int r32, int hi) {
    f32x16 p0, p1;
    if (TYPE == 0) {
        const float cb = cq - m;
#pragma unroll
        for (int g = 0; g < 4; ++g) {
            const f32x4 c0 = *(const LAS f32x4*)(ckv + 8 * g + 4 * hi), c1 = *(const LAS f32x4*)(ckv + 32 + 8 * g + 4 * hi);
#pragma unroll
            for (int e = 0; e < 4; ++e) { p0[4 * g + e] = cb - c0[e]; p1[4 * g + e] = cb - c1[e]; }
        }
    } else {
#pragma unroll
        for (int r = 0; r < 16; ++r) { const int d0 = qpos - (kv0 + crow(r, hi)); p0[r] = biasT[d0 & 127] - m; p1[r] = biasT[(d0 - 32) & 127] - m; }
    }
    const LAS unsigned char* kp = Kt + r32 * KROW + 16 * hi;
#pragma unroll
    for (int d0 = 0; d0 < 4; ++d0) {
        const bf16x8 a0 = *(const LAS bf16x8*)(kp + 32 * d0), a1 = *(const LAS bf16x8*)(kp + 32 * KROW + 32 * d0);
        p0 = __builtin_amdgcn_mfma_f32_32x32x16_bf16(a0, qr[d0], p0, 0, 0, 0);
        p1 = __builtin_amdgcn_mfma_f32_32x32x16_bf16(a1, qr[d0], p1, 0, 0, 0);
    }
    if (TYPE == 0) {
        if (domask) {
#pragma unroll
            for (int r = 0; r < 16; ++r) { const int kv = kv0 + crow(r, hi); if (kv > qpos) p0[r] = NEGBIG; if (kv + 32 > qpos) p1[r] = NEGBIG; }
        }
    } else {
#pragma unroll
        for (int r = 0; r < 16; ++r) { const int d0 = qpos - (kv0 + crow(r, hi)), d1 = d0 - 32; if ((unsigned)d0 >= 128u) p0[r] = NEGBIG; if ((unsigned)d1 >= 128u) p1[r] = NEGBIG; }
    }
    float mx = fmaxf(p0[0], p1[0]);
#pragma unroll
    for (int r = 1; r < 16; ++r) mx = fmaxf(mx, fmaxf(p0[r], p1[r]));
    { const auto rr = __builtin_amdgcn_permlane32_swap(__float_as_uint(mx), __float_as_uint(mx), false, false); mx = fmaxf(__uint_as_float(rr[0]), __uint_as_float(rr[1])); }
    const bool need = first || (mx > ATT_THR);
    if (__any(need)) {
        const float dl = need ? mx : 0.f, alpha = __builtin_amdgcn_exp2f(-dl);
        m += dl; l *= alpha;
#pragma unroll
        for (int r = 0; r < 16; ++r) { p0[r] -= dl; p1[r] -= dl; o[0][r] *= alpha; o[1][r] *= alpha; }
    }
    float s = 0.f;
#pragma unroll
    for (int r = 0; r < 16; ++r) { p0[r] = __builtin_amdgcn_exp2f(p0[r]); p1[r] = __builtin_amdgcn_exp2f(p1[r]); s += p0[r] + p1[r]; }
    l += s;
    bf16x8 pf[4];
    { u32x4 w;
      w.x = cvt_pk_bf16(p0[0], p0[1]); w.y = cvt_pk_bf16(p0[2], p0[3]); w.z = cvt_pk_bf16(p0[4], p0[5]); w.w = cvt_pk_bf16(p0[6], p0[7]); pf[0] = __builtin_bit_cast(bf16x8, w);
      w.x = cvt_pk_bf16(p0[8], p0[9]); w.y = cvt_pk_bf16(p0[10], p0[11]); w.z = cvt_pk_bf16(p0[12], p0[13]); w.w = cvt_pk_bf16(p0[14], p0[15]); pf[1] = __builtin_bit_cast(bf16x8, w);
      w.x = cvt_pk_bf16(p1[0], p1[1]); w.y = cvt_pk_bf16(p1[2], p1[3]); w.z = cvt_pk_bf16(p1[4], p1[5]); w.w = cvt_pk_bf16(p1[6], p1[7]); pf[2] = __builtin_bit_cast(bf16x8, w);
      w.x = cvt_pk_bf16(p1[8], p1[9]); w.y = cvt_pk_bf16(p1[10], p1[11]); w.z = cvt_pk_bf16(p1[12], p1[13]); w.w = cvt_pk_bf16(p1[14], p1[15]); pf[3] = __builtin_bit_cast(bf16x8, w); }
#pragma unroll
    for (int db = 0; db < 2; ++db) {
        const LAS unsigned char* vp = VTt + (32 * db + r32) * vt_stride + 16 * hi;
#pragma unroll
        for (int j = 0; j < 4; ++j) { const bf16x8 a = *(const LAS bf16x8*)(vp + 32 * j); o[db] = __builtin_amdgcn_mfma_f32_32x32x16_bf16(a, pf[j], o[db], 0, 0, 0); }
    }
}
__device__ __forceinline__ void attn_store(const f32x16 (&o)[2], float l, bf16_t* dst  , int hi) {
    const float lt = l + __shfl_xor(l, 32), inv = 1.0f / lt;
#pragma unroll
    for (int db = 0; db < 2; ++db)
#pragma unroll
        for (int g = 0; g < 4; ++g) { u32x2 w; w.x = cvt_pk_bf16(o[db][4 * g] * inv, o[db][4 * g + 1] * inv); w.y = cvt_pk_bf16(o[db][4 * g + 2] * inv, o[db][4 * g + 3] * inv);
            *(u32x2*)(dst + 32 * db + 8 * g + 4 * hi) = w; }
}

constexpr int AVS = 272, A_K = 0, A_VT = 128 * KROW, A_C = A_VT + 64 * AVS, ABUF = A_C + 512;
__device__ __forceinline__ void attnA_unit(LAS unsigned char* lds, const bf16_t* PROJ, const float* CUM, bf16_t* YCAT, int bg, int bl, int h, int qb, int tid, int wave, int lane) {
    const int r32 = lane & 31, hi = lane >> 5, NS = 2 * (qb + 1), q0w = 256 * qb + 32 * wave, qpos = q0w + r32;
    const size_t prow = (size_t)bl * SEQ, grow = (size_t)bg * SEQ;
    bf16x8 qr[4];
    { const bf16_t* qp = PROJ + (prow + qpos) * NPROJ + 64 * h + 8 * hi;
#pragma unroll
      for (int d0 = 0; d0 < 4; ++d0) qr[d0] = *(const bf16x8*)(qp + 16 * d0); }
    const float cq = CUM[(grow + qpos) * 4 + h];
    const int lrow = tid >> 3, lch = tid & 7;
    const bf16_t* kg = PROJ + (prow + lrow) * NPROJ + 256 + 64 * h + 8 * lch;
    const bf16_t* vg = PROJ + (prow + 2 * lane) * NPROJ + 512 + 64 * h + 8 * wave;
    const float* cgp = CUM + (grow + (tid & 127)) * 4 + h;
    const int kst = A_K + lrow * KROW + lch * 16;
    const int vpos = 64 * ((2 * lane) >> 6) + kvperm((2 * lane) & 63), vst = A_VT + (8 * wave) * AVS + vpos * 2;
    u32x4 k0, k1, va, vb; float creg = 0.f;
#define A_LOAD(st) do { const size_t ro = (size_t)(st) * 128 * NPROJ; k0 = *(const u32x4*)(kg + ro); k1 = *(const u32x4*)(kg + ro + (size_t)64 * NPROJ); \
        va = *(const u32x4*)(vg + ro); vb = *(const u32x4*)(vg + ro + NPROJ); if (tid < 128) creg = cgp[(size_t)(st) * 128 * 4]; } while (0)
#define A_STORE(buf) do { LAS unsigned char* bb = lds + (buf) * ABUF; *(LAS u32x4*)(bb + kst) = k0; *(LAS u32x4*)(bb + kst + 64 * KROW) = k1; \
        LAS unsigned* vv = (LAS unsigned*)(bb + vst); \
        vv[0 * (AVS / 4)] = (va.x & 0xffffu) | (vb.x << 16); vv[1 * (AVS / 4)] = (va.x >> 16) | (vb.x & 0xffff0000u); \
        vv[2 * (AVS / 4)] = (va.y & 0xffffu) | (vb.y << 16); vv[3 * (AVS / 4)] = (va.y >> 16) | (vb.y & 0xffff0000u); \
        vv[4 * (AVS / 4)] = (va.z & 0xffffu) | (vb.z << 16); vv[5 * (AVS / 4)] = (va.z >> 16) | (vb.z & 0xffff0000u); \
        vv[6 * (AVS / 4)] = (va.w & 0xffffu) | (vb.w << 16); vv[7 * (AVS / 4)] = (va.w >> 16) | (vb.w & 0xffff0000u); \
        if (tid < 128) *(LAS float*)(bb + A_C + 4 * tid) = creg; } while (0)
    f32x16 o[2];
#pragma unroll
    for (int r = 0; r < 16; ++r) { o[0][r] = 0.f; o[1][r] = 0.f; }
    float m = 0.f, l = 0.f;
    const int t0w = (q0w + 31) >> 6;
    A_LOAD(NS - 1); A_STORE(0); __syncthreads();
    for (int it = 0; it < NS; ++it) {
        const int st = NS - 1 - it;
        if (it + 1 < NS) A_LOAD(st - 1);
        const LAS unsigned char* bb = lds + (it & 1) * ABUF;
#pragma unroll
        for (int sub = 1; sub >= 0; --sub) {
            const int t = 2 * st + sub;
            if (t <= t0w)
                attn_tile<0>(o, m, l, qr, bb + A_K + sub * 64 * KROW, bb + A_VT + sub * 128, AVS, 64 * t, qpos, cq, (const LAS float*)(bb + A_C) + 64 * sub, (const LAS float*)0, 64 * t + 63 > q0w, t == t0w, r32, hi);
        }
        if (it + 1 < NS) A_STORE((it + 1) & 1);
        __syncthreads();
    }
#undef A_LOAD
#undef A_STORE
    attn_store(o, l, YCAT + (grow + qpos) * YW + 64 * h, hi);
}
constexpr int D_K = 0, D_VT = 4 * 64 * KROW, D_VSTRIDE = 528, D_BIAS = D_VT + 64 * D_VSTRIDE, D_END = D_BIAS + 4 * 128 * 4;
__device__ __forceinline__ void attnD_unit(LAS unsigned char* lds, const bf16_t* PROJ, bf16_t* YCAT, const float* relb, const float* sinks, const CAS unsigned char* bucket, int bg, int bl, int kvh, int n, int tid, int wave, int lane) {
    const int r32 = lane & 31, hi = lane >> 5;
    const size_t prow = (size_t)bl * SEQ, grow = (size_t)bg * SEQ;
#pragma unroll
    for (int it = 0; it < 4; ++it) {
        const int idx = tid + 512 * it, i = idx >> 3, ch = idx & 7, pos = 128 * (n - 1) + i;
        if (pos >= 0) *(LAS u32x4*)(lds + D_K + (i >> 6) * (64 * KROW) + (i & 63) * KROW + ch * 16) = *(const u32x4*)(PROJ + (prow + pos) * NPROJ + 2560 + 64 * kvh + 8 * ch);
    }
#pragma unroll
    for (int it = 0; it < 2; ++it) {
        const int i = 2 * (lane + 64 * it), pos = 128 * (n - 1) + i;
        if (pos >= 0) {
            const bf16_t* src = PROJ + (prow + pos) * NPROJ + 2688 + 64 * kvh + 8 * wave;
            const u32x4 va = *(const u32x4*)src, vb = *(const u32x4*)(src + NPROJ);
            LAS unsigned* vv = (LAS unsigned*)(lds + D_VT + (8 * wave) * D_VSTRIDE + ((i >> 6) * 64 + kvperm(i & 63)) * 2);
            vv[0 * (D_VSTRIDE / 4)] = (va.x & 0xffffu) | (vb.x << 16); vv[1 * (D_VSTRIDE / 4)] = (va.x >> 16) | (vb.x & 0xffff0000u);
            vv[2 * (D_VSTRIDE / 4)] = (va.y & 0xffffu) | (vb.y << 16); vv[3 * (D_VSTRIDE / 4)] = (va.y >> 16) | (vb.y & 0xffff0000u);
            vv[4 * (D_VSTRIDE / 4)] = (va.z & 0xffffu) | (vb.z << 16); vv[5 * (D_VSTRIDE / 4)] = (va.z >> 16) | (vb.z & 0xffff0000u);
            vv[6 * (D_VSTRIDE / 4)] = (va.w & 0xffffu) | (vb.w << 16); vv[7 * (D_VSTRIDE / 4)] = (va.w >> 16) | (vb.w & 0xffff0000u);
        }
    }
    { const int g = tid >> 7, dist = tid & 127; ((LAS float*)(lds + D_BIAS))[tid] = relb[(int)bucket[dist] * 8 + 4 * kvh + g] * LOG2E; }
    __syncthreads();
#pragma unroll 1
    for (int k = wave; k < 16; k += 8) {
        const int g = k >> 2, j = k & 3, hq = 4 * kvh + g, qpos = 128 * n + 32 * j + r32;
        bf16x8 qr[4];
        { const bf16_t* qp = PROJ + (prow + qpos) * NPROJ + 2048 + 64 * hq + 8 * hi;
#pragma unroll
          for (int d0 = 0; d0 < 4; ++d0) qr[d0] = *(const bf16x8*)(qp + 16 * d0); }
        f32x16 o[2];
#pragma unroll
        for (int r = 0; r < 16; ++r) { o[0][r] = 0.f; o[1][r] = 0.f; }
        float m = sinks[hq] * LOG2E, l = (hi == 0) ? 1.0f : 0.0f;
        int jlo = (j >= 2) ? 1 : 0; const int jhi = (j >= 2) ? 3 : 2; if (n == 0 && jlo < 2) jlo = 2;
        for (int jt = jlo; jt <= jhi; ++jt)
            attn_tile<1>(o, m, l, qr, lds + D_K + jt * (64 * KROW), lds + D_VT + jt * 128, D_VSTRIDE, 128 * (n - 1) + 64 * jt, qpos, 0.f, (const LAS float*)0, (const LAS float*)(lds + D_BIAS) + 128 * g, true, false, r32, hi);
        attn_store(o, l, YCAT + (grow + qpos) * YW + 768 + 64 * hq, hi);
    }
    __syncthreads();
}
constexpr int CW_OFF = 94 * 256 * 4;
__device__ __forceinline__ void conv_weights_to_lds(LAS unsigned char* lds, const float* wdw, int tid) {
    LAS float* w = (LAS float*)(lds + CW_OFF);
#pragma unroll
    for (int it = 0; it < 4; ++it) { const int idx = tid + 512 * it; if (idx < 31 * 64) *(LAS f32x4*)(w + 4 * idx) = *(const f32x4*)(wdw + 4 * idx); }
}
__device__ __forceinline__ void conv_unit(LAS unsigned char* lds, const bf16_t* PROJ, bf16_t* YCAT, const float* wshort, const float* dwb, const float* lng, const float* lnb, int bg, int bl, int tb, int tid, int wave, int lane) {
    const size_t prow = (size_t)bl * SEQ, grow = (size_t)bg * SEQ; const int t0 = 64 * tb;
    {
        const int grp = tid & 31;
        f32x4 w0[3], w1[3];
#pragma unroll
        for (int k = 0; k < 3; ++k) { w0[k] = *(const f32x4*)(wshort + k * 256 + 8 * grp); w1[k] = *(const f32x4*)(wshort + k * 256 + 8 * grp + 4); }
#pragma unroll 2
        for (int it = 0; it < 4; ++it) {
            const int tok = (tid >> 5) + 16 * it, t = t0 + tok;
            const bf16_t* src = PROJ + (prow + t) * NPROJ + 768 + 8 * grp;
            u32x4 c[3], x[3];
#pragma unroll
            for (int k = 0; k < 3; ++k) {
                const int tt = t - 2 + k;
                if (tt >= 0) { c[k] = *(const u32x4*)(src + (k - 2) * NPROJ + 256); x[k] = *(const u32x4*)(src + (k - 2) * NPROJ + 512); }
                else { c[k] = (u32x4){0u, 0u, 0u, 0u}; x[k] = (u32x4){0u, 0u, 0u, 0u}; }
            }
            const u32x4 b = *(const u32x4*)src;
            float acc[8];
#pragma unroll
            for (int e = 0; e < 8; ++e) acc[e] = 0.f;
#pragma unroll
            for (int k = 0; k < 3; ++k) {
                acc[0] += w0[k][0] * (bflo(c[k].x) * bflo(x[k].x)); acc[1] += w0[k][1] * (bfhi(c[k].x) * bfhi(x[k].x)); acc[2] += w0[k][2] * (bflo(c[k].y) * bflo(x[k].y)); acc[3] += w0[k][3] * (bfhi(c[k].y) * bfhi(x[k].y));
                acc[4] += w1[k][0] * (bflo(c[k].z) * bflo(x[k].z)); acc[5] += w1[k][1] * (bfhi(c[k].z) * bfhi(x[k].z)); acc[6] += w1[k][2] * (bflo(c[k].w) * bflo(x[k].w)); acc[7] += w1[k][3] * (bfhi(c[k].w) * bfhi(x[k].w));
            }
            u32x4 w; w.x = cvt_pk_bf16(bflo(b.x) * acc[0], bfhi(b.x) * acc[1]); w.y = cvt_pk_bf16(bflo(b.y) * acc[2], bfhi(b.y) * acc[3]); w.z = cvt_pk_bf16(bflo(b.z) * acc[4], bfhi(b.z) * acc[5]); w.w = cvt_pk_bf16(bflo(b.w) * acc[6], bfhi(b.w) * acc[7]);
            *(u32x4*)(YCAT + (grow + t) * YW + 256 + 8 * grp) = w;
        }
    }
    LAS float* glu = (LAS float*)lds;
#pragma unroll 3
    for (int it = 0; it < 6; ++it) {
        const int idx = tid + 512 * it;
        if (idx < 94 * 32) {
            const int r = idx >> 5, grp = idx & 31, tt = t0 - 30 + r;
            f32x4 g0 = {0.f, 0.f, 0.f, 0.f}, g1 = {0.f, 0.f, 0.f, 0.f};
            if (tt >= 0) {
                const bf16_t* src = PROJ + (prow + tt) * NPROJ + 1536 + 8 * grp;
                const u32x4 a = *(const u32x4*)src, s = *(const u32x4*)(src + 256);
                g0[0] = bflo(a.x) * sigmoid_f(bflo(s.x)); g0[1] = bfhi(a.x) * sigmoid_f(bfhi(s.x)); g0[2] = bflo(a.y) * sigmoid_f(bflo(s.y)); g0[3] = bfhi(a.y) * sigmoid_f(bfhi(s.y));
                g1[0] = bflo(a.z) * sigmoid_f(bflo(s.z)); g1[1] = bfhi(a.z) * sigmoid_f(bfhi(s.z)); g1[2] = bflo(a.w) * sigmoid_f(bflo(s.w)); g1[3] = bfhi(a.w) * sigmoid_f(bfhi(s.w));
            }
            *(LAS f32x4*)(glu + r * 256 + 8 * grp) = g0; *(LAS f32x4*)(glu + r * 256 + 8 * grp + 4) = g1;
        }
    }
    __syncthreads();
    {
        f32x4 acc[8];
#pragma unroll
        for (int i = 0; i < 8; ++i) acc[i] = (f32x4){0.f, 0.f, 0.f, 0.f};
        const LAS float* gb = glu + (8 * wave) * 256 + 4 * lane;
        const LAS float* wl = (const LAS float*)(lds + CW_OFF) + 4 * lane;
#pragma unroll 2
        for (int k = 0; k < 31; ++k) {
            const f32x4 wk = *(const LAS f32x4*)(wl + k * 256);
#pragma unroll
            for (int i = 0; i < 8; ++i) acc[i] = acc[i] + wk * *(const LAS f32x4*)(gb + (i + k) * 256);
        }
        const f32x4 bias = *(const f32x4*)(dwb + 4 * lane), gain = *(const f32x4*)(lng + 4 * lane), lb = *(const f32x4*)(lnb + 4 * lane);
#pragma unroll
        for (int i = 0; i < 8; ++i) {
            const f32x4 v = acc[i] + bias;
            const float mean = wave_sum((v[0] + v[1]) + (v[2] + v[3])) * (1.0f / 256.0f);
            const f32x4 d = v - mean;
            const float var = wave_sum((d[0] * d[0] + d[1] * d[1]) + (d[2] * d[2] + d[3] * d[3])) * (1.0f / 256.0f);
            const float rs = 1.0f / sqrtf(var + EPS);
            f32x4 y = (d * rs) * gain + lb;
#pragma unroll
            for (int e = 0; e < 4; ++e) y[e] = y[e] * sigmoid_f(y[e]);
            u32x2 w; w.x = cvt_pk_bf16(y[0], y[1]); w.y = cvt_pk_bf16(y[2], y[3]);
            *(u32x2*)(YCAT + (grow + t0 + 8 * wave + i) * YW + 512 + 4 * lane) = w;
        }
    }
    __syncthreads();
}
__device__ __forceinline__ void mixer_phase(const CAS Args* a, int L, int half, LAS unsigned char* lds, int bid, int tid, int wave, int lane) {
    const bf16_t* PROJ = (const bf16_t*)(a->ws + WS_PROJ); bf16_t* YCAT = (bf16_t*)(a->ws + WS_YCAT); const float* CUM = (const float*)(a->ws + WS_CUM);
    const int G = gridDim.x, B0 = 16 * half;
    for (int u = bid; u < 256; u += G) {
        const int bl = u >> 4, h = (u >> 2) & 3, pr = u & 3;
        attnA_unit(lds, PROJ, CUM, YCAT, B0 + bl, bl, h, 7 - pr, tid, wave, lane);
        attnA_unit(lds, PROJ, CUM, YCAT, B0 + bl, bl, h, pr, tid, wave, lane);
    }
    for (int u = bid; u < 512; u += G) {
        const int bl = u >> 5, kvh = (u >> 4) & 1, n = u & 15;
        attnD_unit(lds, PROJ, YCAT, a->in[16], a->in[15] + L * 8, a->bucket, B0 + bl, bl, kvh, n, tid, wave, lane);
    }
    conv_weights_to_lds(lds, a->in[11] + (size_t)L * 31 * 256, tid);
    for (int u = bid; u < 512; u += G) {
        const int bl = u >> 5, tb = u & 31;
        conv_unit(lds, PROJ, YCAT, a->in[10] + (size_t)L * 3 * 256, a->in[12] + L * 256, a->in[13] + L * 256, a->in[14] + L * 256, B0 + bl, bl, tb, tid, wave, lane);
    }
}

#define XB_TMO      128
#define XB_XCNT(j)  (256  + 64 * (j))
#define XB_XSUB(j)  (1280 + 64 * (j))
#define XB_XGEN(j)  (2304 + 64 * (j))
#define XB_TOP      3328
#define XB_TOPGEN   3392
#define XCD_BAR_WORDS 3456
#define XB_SPIN_CAP (1u << 22)

__device__ __forceinline__ unsigned xb_ld(unsigned* p)              { return __hip_atomic_load(p, __ATOMIC_RELAXED, __HIP_MEMORY_SCOPE_AGENT); }
__device__ __forceinline__ unsigned xb_add(unsigned* p, unsigned v) { return __hip_atomic_fetch_add(p, v, __ATOMIC_RELAXED, __HIP_MEMORY_SCOPE_AGENT); }
__device__ __forceinline__ unsigned xb_xcc_id() { return (unsigned)__builtin_amdgcn_s_getreg((3 << 11) | 20) & 0xFu; }
#define XB_SPIN(cond, bar) do { unsigned _sp = 0; while (cond) { __builtin_amdgcn_s_sleep(1); \
    if ((++_sp & 255u) == 0u) { if (xb_ld(&(bar)[XB_TMO])) break; if (_sp > XB_SPIN_CAP) { atomicAdd(&(bar)[XB_TMO], 1u); break; } } } } while (0)

struct XcdBarrier {
    unsigned* bar; unsigned x;
    volatile LAS unsigned* st;
};

__device__ __forceinline__ XcdBarrier xcd_barrier_post(unsigned* bar, volatile LAS unsigned* st) {
    XcdBarrier b; b.bar = bar; b.x = xb_xcc_id(); b.st = st;
    if (threadIdx.x == 0) (void)xb_add(&bar[XB_XCNT(b.x)], 1u);
    return b;
}
__device__ __forceinline__ void xcd_barrier_complete(unsigned* bar, unsigned x, unsigned& nloc, unsigned& nx) {
    const unsigned G = gridDim.x * gridDim.y * gridDim.z;
    unsigned sum, cnt, mine, sp = 0u;
    for (;;) {
        sum = 0u; cnt = 0u; mine = 0u;
#pragma unroll
        for (unsigned j = 0; j < 16; ++j) { const unsigned c = xb_ld(&bar[XB_XCNT(j)]); sum += c; cnt += (c > 0u) ? 1u : 0u; mine = (j == x) ? c : mine; }
        if (sum == G) break;
        __builtin_amdgcn_s_sleep(1);
        if ((++sp & 255u) == 0u) { if (xb_ld(&bar[XB_TMO])) break; if (sp > XB_SPIN_CAP) { atomicAdd(&bar[XB_TMO], 1u); break; } }
    }
    nloc = mine > 0u ? mine : 1u; nx = cnt > 0u ? cnt : 1u;
}

__device__ __forceinline__ void xcd_barrier(const XcdBarrier& b) {
    asm volatile("s_waitcnt vmcnt(0)" ::: "memory");
    __syncthreads();
    if (threadIdx.x == 0) {
        unsigned* bar = b.bar;
        __builtin_amdgcn_s_waitcnt(0);
        unsigned nloc = b.st[0], nx = b.st[1];
        if (nloc == 0u) { xcd_barrier_complete(bar, b.x, nloc, nx); b.st[0] = nloc; b.st[1] = nx; }
        const unsigned old = xb_add(&bar[XB_XSUB(b.x)], 1u);
        const unsigned gen = old / nloc;
        if (old + 1u == (gen + 1u) * nloc) {
            __builtin_amdgcn_fence(__ATOMIC_RELEASE, "agent");
            asm volatile("s_waitcnt vmcnt(0)" ::: "memory");
            const unsigned og = xb_add(&bar[XB_TOP], 1u);
            const unsigned tg = og / nx;
            if (og + 1u == (tg + 1u) * nx) xb_add(&bar[XB_TOPGEN], 1u);
            else XB_SPIN(xb_ld(&bar[XB_TOPGEN]) == tg, bar);
            __builtin_amdgcn_fence(__ATOMIC_ACQUIRE, "agent");
            xb_add(&bar[XB_XGEN(b.x)], 1u);
            asm volatile("s_waitcnt vmcnt(0)" ::: "memory");
        } else {
            XB_SPIN(xb_ld(&bar[XB_XGEN(b.x)]) == gen, bar);
            __builtin_amdgcn_fence(__ATOMIC_ACQUIRE, "agent");
            asm volatile("s_waitcnt vmcnt(0)" ::: "memory");
        }
    }
    __syncthreads();
}

__global__ void __launch_bounds__(NTHREADS, 2) mega(Args a_) {
    extern __shared__ __attribute__((aligned(16))) unsigned char lds_raw[];
    LAS unsigned char* lds = (LAS unsigned char*)lds_raw;
    const int ph_lo = a_.ph_lo, ph_hi = a_.ph_hi;
    { volatile LAS unsigned* bst = (volatile LAS unsigned*)(lds + 131072 + 64);
      if (threadIdx.x == 0) { bst[0] = 0u; bst[1] = 0u; }
      __syncthreads();
      (void)xcd_barrier_post((unsigned*)(a_.ws + WS_CTL_BAR), bst); }
    for (int ph = ph_lo; ph < ph_hi; ++ph) {
        const CAS Args* a = (const CAS Args*)__builtin_amdgcn_kernarg_segment_ptr();
        asm volatile("" : "+s"(a));
#define PH_IDS int tid = threadIdx.x; asm volatile("" : "+v"(tid)); const int lane = tid & 63, wave = __builtin_amdgcn_readfirstlane(tid >> 6); int bid = blockIdx.x; asm volatile("" : "+s"(bid)); const int G = gridDim.x, gw = bid * NWAVES + wave, NGW = G * NWAVES; (void)lane; (void)gw; (void)NGW; (void)G;
        unsigned char* ws = a->ws; float* OUT = a->out; unsigned short* H16 = (unsigned short*)(ws + WS_U);
        const int L = ph / PH_PER_LAYER, s = ph % PH_PER_LAYER;
        if (s == 0 && L > 0) continue;
        unsigned char* wsw = ws + ((L & 1) ? WS_WB - WS_W : 0);
        bf16_t* U = (bf16_t*)a->out; bf16_t* HID = (bf16_t*)(ws + WS_HID); bf16_t* F = (bf16_t*)(ws + WS_F); bf16_t* F2 = (bf16_t*)(ws + WS_F2);
        bf16_t* PROJ = (bf16_t*)(ws + WS_PROJ); bf16_t* YCAT = (bf16_t*)(ws + WS_YCAT); bf16_t* MERGED = (bf16_t*)(ws + WS_MERGED);
        float* LOGF = (float*)(ws + WS_LOGF); float* CUM = (float*)(ws + WS_CUM); bf16_t* PBF = (bf16_t*)(ws + WS_PBF);
        if (s == 0) { PH_IDS
            wconv_phase(a, L, -1, lds, gw, NGW, wave, lane);
            if (L == 0) { RowArgs R{a->in[0], nullptr, nullptr, nullptr, nullptr, nullptr, nullptr, 0.f, a->in[2], U, nullptr, nullptr, nullptr, nullptr, nullptr}; row_pass(R, gw, NGW, lane); }
            __syncthreads();
        } else if (s == 1 || s == 12) { PH_IDS
            pg8::Gemm g{U, (const bf16_t*)(wsw + (s == 1 ? W_GU1 : W_GU2)), M, 2 * FF, DM}; pg8::StaticOrder S; S.init(M, 2 * FF, G, bid);
            pg8::EpiSwiglu E{HID, FF};
            pg8::gemm_phase<pg8::EpiSwiglu, pg8::StaticOrder, true, true>(lds, g, S, E);
        } else if (s == 2 || s == 10 || s == 13 || s == 15) { PH_IDS
            const int nrep = (s == 15) ? 2 : 1;
            for (int rep = 0; rep < nrep; ++rep) {
                pg8::Gemm g; bf16_t* out;
                if (s == 2) { g = pg8::Gemm{HID, (const bf16_t*)(wsw + W_D1), M, DM, FF}; out = F; }
                else if (s == 13) { g = pg8::Gemm{HID, (const bf16_t*)(wsw + W_D2), M, DM, FF}; out = F; }
                else if (s == 10) { g = pg8::Gemm{MERGED, (const bf16_t*)(wsw + W_O), M, DM, DM}; out = F; }
                else if (rep == 0) { g = pg8::Gemm{U, (const bf16_t*)(wsw + W_PG), M, DM, DM}; out = F; }
                else { g = pg8::Gemm{PBF, (const bf16_t*)(wsw + W_PLE), M, DM, PLE}; out = F2; }
                pg8::StaticOrder S; S.init(M, DM, G, bid);
                pg8::EpiBf16 E{out, DM};
                pg8::gemm_phase<pg8::EpiBf16, pg8::StaticOrder, true, true>(lds, g, S, E);
            }
        } else if (s == 4 || s == 7) { PH_IDS
            const int half = (s == 7) ? 1 : 0;
            if (half == 0 && wave == 0) { for (int q = bid; q < NB * 4; q += G) cumsum_seq(LOGF, CUM, q, lane); }
            pg8::Gemm g{U + (size_t)half * MH * DM, (const bf16_t*)(wsw + W_IN), MH, NPROJ, DM}; pg8::StaticOrder S; S.init(MH, NPROJ, G, bid);
            pg8::EpiProj E{PROJ, NPROJ, a->in[9] + (size_t)L * 4096, QSCALE};
            pg8::gemm_phase<pg8::EpiProj, pg8::StaticOrder, true, true>(lds, g, S, E);
        } else if (s == 5 || s == 8) { PH_IDS
            mixer_phase(a, L, (s == 8) ? 1 : 0, lds, bid, tid, wave, lane);
            if (L + 1 < DEPTH) wconv_phase(a, L + 1, (s == 8) ? 1 : 0, lds, gw, NGW, wave, lane);
        } else if (s == 6 || s == 9) { PH_IDS
            const int half = (s == 9) ? 1 : 0;
            pg8::Gemm g{YCAT + (size_t)half * MH * YW, (const bf16_t*)(wsw + W_BR), MH, DM, YW}; pg8::StaticOrder S; S.init(MH, DM, G, bid);
            pg8::EpiMerge E{MERGED + (size_t)half * MH * DM, DM, PROJ + 2816, NPROJ};
            pg8::gemm_phase<pg8::EpiMerge, pg8::StaticOrder, true, true>(lds, g, S, E);
        } else { PH_IDS
            RowArgs R;
            const bool last = (L + 1 == DEPTH);
            if (s == 3)       R = RowArgs{L == 0 ? a->in[0] : nullptr, H16, nullptr, H16, F, nullptr, a->in[5] + L * DM, 0.5f, a->in[6] + L * DM, U, (const float*)(wsw + W_AF), a->in[8] + L * 4, LOGF, nullptr, nullptr};
            else if (s == 11) R = RowArgs{nullptr, H16, nullptr, H16, F, nullptr, a->in[22] + L * DM, 1.0f, a->in[23] + L * DM, U, nullptr, nullptr, nullptr, nullptr, nullptr};
            else if (s == 14) R = RowArgs{nullptr, H16, nullptr, H16, F, nullptr, a->in[26] + L * DM, 0.5f, a->in[27] + L * DM, U, nullptr, nullptr, nullptr, a->in[1] + (size_t)L * M * PLE, PBF};
            else              R = RowArgs{nullptr, H16, last ? OUT : nullptr, H16, F, F2, a->in[30] + L * DM, 1.0f, last ? nullptr : a->in[2] + (L + 1) * DM, U, nullptr, nullptr, nullptr, nullptr, nullptr};
            row_pass(R, gw, NGW, lane);
        }
        if (ph + 1 < ph_hi) { if (ph == ph_lo) cg::this_grid().sync(); else { XcdBarrier xbar; xbar.bar = (unsigned*)(a->ws + WS_CTL_BAR); xbar.x = xb_xcc_id(); xbar.st = (volatile LAS unsigned*)(lds + 131072 + 64); xcd_barrier(xbar); } }
    }
}

extern "C" void kernel_launch(void* const* d_in, const int* in_sizes, int n_in, void* d_out, int out_size, void* d_ws, size_t ws_size, hipStream_t stream) {
    static int grid = 0;
    if (grid == 0) {
        if (n_in != 31 || out_size != M * DM || ws_size < WS_NEED) { fprintf(stderr, "kernel_launch: unexpected shapes (n_in %d, out %d, ws %zu)\n", n_in, out_size, ws_size); grid = -1; return; }
        int dev = 0, cus = 0, per_cu = 0;
        if (hipGetDevice(&dev) != hipSuccess || hipDeviceGetAttribute(&cus, hipDeviceAttributeMultiprocessorCount, dev) != hipSuccess) { grid = -1; return; }
        if (hipFuncSetAttribute((const void*)mega, hipFuncAttributeMaxDynamicSharedMemorySize, LDS_BYTES) != hipSuccess) { fprintf(stderr, "kernel_launch: hipFuncSetAttribute failed\n"); grid = -1; return; }
        if (hipOccupancyMaxActiveBlocksPerMultiprocessor(&per_cu, (const void*)mega, NTHREADS, LDS_BYTES) != hipSuccess || per_cu < 1) { fprintf(stderr, "kernel_launch: occupancy query says %d\n", per_cu); per_cu = 1; }
        (void)hipGetLastError();
        grid = cus * per_cu;
        fprintf(stderr, "kernel_launch: grid %d (cus %d x %d)\n", grid, cus, per_cu);
    }
    if (grid < 0) return;
    Args a{};
    for (int i = 0; i < 31; ++i) a.in[i] = (const float*)d_in[i];
    a.out = (float*)d_out; a.ws = (unsigned char*)d_ws;
    for (int d = 0; d < 128; ++d) {
        int bkt;
        if (d < 16) bkt = d;
        else { const float v = logf((float)d / 16.0f) / (float)log(128.0 / 16.0) * 16.0f; bkt = 16 + (int)v; if (bkt > 31) bkt = 31; }
        a.bucket[d] = (unsigned char)bkt;
    }
#if MK_ONE_LAUNCH
    if (hipMemsetAsync(d_ws, 0, CTL_ZERO_BYTES, stream) != hipSuccess) { fprintf(stderr, "kernel_launch: memset failed\n"); return; }
    a.ph_lo = 0; a.ph_hi = N_PHASES;
    void* args[] = {&a};
    hipError_t e = hipLaunchCooperativeKernel((const void*)mega, dim3(grid), dim3(NTHREADS), args, LDS_BYTES, stream);
    if (e != hipSuccess) fprintf(stderr, "kernel_launch: cooperative launch failed: %s (grid %d)\n", hipGetErrorString(e), grid);
#else
    for (int ph = 0; ph < N_PHASES; ++ph) {
        a.ph_lo = ph; a.ph_hi = ph + 1;
        hipLaunchKernelGGL(mega, dim3(grid), dim3(NTHREADS), LDS_BYTES, stream, a);
    }
#endif
}
```
